# Optimizing an MI355X kernel written in HIP

```python
import math, functools
import jax, jax.numpy as jnp
from jax import lax
import numpy as np

D_MODEL = 1024
BATCH = 4
SEQ = 8192
DEPTH = 1
DEC_BATCH = 32
DEC_SEQ = 64
PAST_LEN = 1024

CHUNK = 64
N_HEADS = 8
HEAD_DIM = 64
V_DIM = 2 * HEAD_DIM
Q_WIDTH = N_HEADS * 2 * HEAD_DIM
ATTN_WIDTH = N_HEADS * V_DIM
LRU_WIDTH = D_MODEL
LRU_BLOCKS = 16
LRU_BLOCK = LRU_WIDTH // LRU_BLOCKS
CONV_WIDTH = 4
LRU_C = 8.0
D_FF = 4 * D_MODEL
Q_BLOCK = 128
EPS = 1e-6
IN_WIDTH = 3 * Q_WIDTH + 2 * LRU_WIDTH + 2 * D_MODEL
IN_SPLITS = (Q_WIDTH, 2 * Q_WIDTH, 3 * Q_WIDTH, 3 * Q_WIDTH + LRU_WIDTH,
             3 * Q_WIDTH + 2 * LRU_WIDTH, 3 * Q_WIDTH + 2 * LRU_WIDTH + D_MODEL)

kernel_name = "diffattn_rglru_gated_streaming_encoder"


def _rms_norm(x, g):
    xf = x.astype(jnp.float32)
    xf = xf * lax.rsqrt(jnp.mean(jnp.square(xf), axis=-1, keepdims=True) + EPS)
    return (xf * g.astype(jnp.float32)).astype(x.dtype)


def _diff_attention(q, k, v, q_pos, k_pos, lam, head_gain, lam_init):
    scale = HEAD_DIM ** -0.5
    s = jnp.einsum("bqhcd,bkhcd->bhcqk", q.astype(jnp.float32), k.astype(jnp.float32)) * scale
    visible = (k_pos[None, :] // CHUNK) <= (q_pos[:, None] // CHUNK)
    s = jnp.where(visible, s, -jnp.inf)
    p = jax.nn.softmax(s, axis=-1)
    a = p[:, :, 0] - lam * p[:, :, 1]
    o = jnp.einsum("bhqk,bkhe->bqhe", a, v.astype(jnp.float32))
    o = o * lax.rsqrt(jnp.mean(jnp.square(o), axis=-1, keepdims=True) + EPS)
    return o * head_gain.astype(jnp.float32) * (1.0 - lam_init)


def _attend_prompt(q, k, v, lam, head_gain, lam_init):
    b, s = q.shape[0], q.shape[1]
    nb = s // Q_BLOCK
    qb = q.reshape(b, nb, Q_BLOCK, N_HEADS, 2, HEAD_DIM).swapaxes(0, 1)
    k_pos = jnp.arange(s)

    def one_block(args):
        q_blk, start = args
        q_pos = start + jnp.arange(Q_BLOCK)
        return _diff_attention(q_blk, k, v, q_pos, k_pos, lam, head_gain, lam_init)

    o = lax.map(one_block, (qb, jnp.arange(nb) * Q_BLOCK))
    return o.swapaxes(0, 1).reshape(b, s, ATTN_WIDTH)


def _attend_sample(cache_k, cache_v, q, k, v, lam, head_gain, lam_init):
    b, s = q.shape[0], q.shape[1]
    past = cache_k.shape[1]
    kc = jnp.concatenate([cache_k.astype(k.dtype), k], axis=1)
    vc = jnp.concatenate([cache_v.astype(v.dtype), v], axis=1)
    q_pos = past + jnp.arange(s)
    k_pos = jnp.arange(past + s)
    o = _diff_attention(q, kc, vc, q_pos, k_pos, lam, head_gain, lam_init)
    return o.reshape(b, s, ATTN_WIDTH)


def _lin_combine(left, right):
    a1, b1 = left
    a2, b2 = right
    return a1 * a2, a2 * b1 + b2


def _rglru_branch(x_lru, g_lru, conv_state, h0, conv_w, conv_b, w_r, b_r, w_i, b_i, lru_lambda):
    b, s, _ = x_lru.shape
    xpad = jnp.concatenate([conv_state.astype(x_lru.dtype), x_lru], axis=1)
    xc = conv_b + sum(conv_w[j] * xpad[:, j:j + s] for j in range(CONV_WIDTH))
    new_conv = xpad[:, -(CONV_WIDTH - 1):]
    xb = xc.reshape(b, s, LRU_BLOCKS, LRU_BLOCK)
    r = jax.nn.sigmoid(jnp.einsum("bsnc,ncd->bsnd", xb, w_r).reshape(b, s, LRU_WIDTH) + b_r)
    i = jax.nn.sigmoid(jnp.einsum("bsnc,ncd->bsnd", xb, w_i).reshape(b, s, LRU_WIDTH) + b_i)
    log_a = -LRU_C * r.astype(jnp.float32) * jax.nn.softplus(-lru_lambda.astype(jnp.float32))
    a = jnp.exp(log_a)
    u = jnp.sqrt(-jnp.expm1(2.0 * log_a)) * (i * xc).astype(jnp.float32)
    a_cum, h = lax.associative_scan(_lin_combine, (a, u), axis=1)
    h = h + a_cum * h0.astype(jnp.float32)[:, None, :]
    y = h * jax.nn.gelu(g_lru.astype(jnp.float32))
    return y, new_conv, h[:, -1]


def _layer(x, conv_state, h0, attend, g_mix, g_mlp, w_in, lam_q, lam_k, head_gain,
           conv_w, conv_b, w_r, b_r, w_i, b_i, lru_lambda, w_ba, w_bl, w_o, w_up, w_down, lam_init):
    b, s, _ = x.shape
    xn = _rms_norm(x, g_mix)
    proj = xn @ w_in
    q, k, v, x_lru, g_lru, gate_a, gate_b = jnp.split(proj, IN_SPLITS, axis=-1)
    q = q.reshape(b, s, N_HEADS, 2, HEAD_DIM)
    k = k.reshape(b, s, N_HEADS, 2, HEAD_DIM)
    v = v.reshape(b, s, N_HEADS, V_DIM)
    lqf, lkf = lam_q.astype(jnp.float32), lam_k.astype(jnp.float32)
    lam = jnp.exp(jnp.sum(lqf[0] * lkf[0])) - jnp.exp(jnp.sum(lqf[1] * lkf[1])) + lam_init
    o_attn = attend(q, k, v, lam, head_gain, lam_init)
    y_lru, conv_new, h_new = _rglru_branch(x_lru, g_lru, conv_state, h0, conv_w, conv_b,
                                           w_r, b_r, w_i, b_i, lru_lambda)
    merged = (jax.nn.sigmoid(gate_a.astype(jnp.float32)) * (o_attn.astype(x.dtype) @ w_ba)
              + jax.nn.sigmoid(gate_b.astype(jnp.float32)) * (y_lru.astype(x.dtype) @ w_bl))
    h = x + (merged.astype(x.dtype) @ w_o).astype(x.dtype)
    hn = _rms_norm(h, g_mlp)
    out = h + (jnp.square(jax.nn.relu(hn @ w_up)) @ w_down).astype(x.dtype)
    return out, k, v, conv_new, h_new.astype(x.dtype)


def setup_inputs(seed: int = 0) -> dict:
    key = jax.random.key(seed)
    ks = jax.random.split(key, 32)
    f32 = jnp.float32
    nrm = lambda k, shape, sc: jax.random.normal(k, shape, f32) * sc
    a_c = jax.random.uniform(ks[17], (DEPTH, LRU_WIDTH), f32, 0.9, 0.999)
    s_l = a_c ** (1.0 / LRU_C)
    lru_lambda = jnp.log(s_l) - jnp.log1p(-s_l)
    return {
        "x_prompt": nrm(ks[0], (BATCH, SEQ, D_MODEL), 1.0),
        "x_sample": nrm(ks[1], (DEC_BATCH, DEC_SEQ, D_MODEL), 1.0),
        "cache_k": nrm(ks[2], (DEPTH, DEC_BATCH, PAST_LEN, N_HEADS, 2, HEAD_DIM), 1.0),
        "cache_v": nrm(ks[3], (DEPTH, DEC_BATCH, PAST_LEN, N_HEADS, V_DIM), 1.0),
        "state_conv": nrm(ks[4], (DEPTH, DEC_BATCH, CONV_WIDTH - 1, LRU_WIDTH), 1.0),
        "state_lru": nrm(ks[5], (DEPTH, DEC_BATCH, LRU_WIDTH), 0.5),
        "norm_mix": 1.0 + nrm(ks[6], (DEPTH, D_MODEL), 0.02),
        "norm_mlp": 1.0 + nrm(ks[7], (DEPTH, D_MODEL), 0.02),
        "norm_final": 1.0 + nrm(ks[8], (D_MODEL,), 0.02),
        "w_in": nrm(ks[9], (DEPTH, D_MODEL, IN_WIDTH), D_MODEL ** -0.5),
        "lambda_q": nrm(ks[10], (DEPTH, 2, HEAD_DIM), 0.1),
        "lambda_k": nrm(ks[11], (DEPTH, 2, HEAD_DIM), 0.1),
        "head_gain": 1.0 + nrm(ks[12], (DEPTH, V_DIM), 0.02),
        "conv_w": nrm(ks[13], (DEPTH, CONV_WIDTH, LRU_WIDTH), CONV_WIDTH ** -0.5),
        "conv_b": nrm(ks[14], (DEPTH, LRU_WIDTH), 0.01),
        "w_rgate": nrm(ks[15], (DEPTH, LRU_BLOCKS, LRU_BLOCK, LRU_BLOCK), LRU_BLOCK ** -0.5),
        "b_rgate": nrm(ks[16], (DEPTH, LRU_WIDTH), 0.01),
        "w_igate": nrm(ks[18], (DEPTH, LRU_BLOCKS, LRU_BLOCK, LRU_BLOCK), LRU_BLOCK ** -0.5),
        "b_igate": nrm(ks[19], (DEPTH, LRU_WIDTH), 0.01),
        "lru_lambda": lru_lambda,
        "w_branch_attn": nrm(ks[20], (DEPTH, ATTN_WIDTH, D_MODEL), ATTN_WIDTH ** -0.5),
        "w_branch_lru": nrm(ks[21], (DEPTH, LRU_WIDTH, D_MODEL), LRU_WIDTH ** -0.5),
        "w_out": nrm(ks[22], (DEPTH, D_MODEL, D_MODEL), D_MODEL ** -0.5),
        "w_mlp_up": nrm(ks[23], (DEPTH, D_MODEL, D_FF), D_MODEL ** -0.5),
        "w_mlp_down": nrm(ks[24], (DEPTH, D_FF, D_MODEL), D_FF ** -0.5),
    }


def reference(x_prompt, x_sample, cache_k, cache_v, state_conv, state_lru,
              norm_mix, norm_mlp, norm_final, w_in, lambda_q, lambda_k, head_gain,
              conv_w, conv_b, w_rgate, b_rgate, w_igate, b_igate, lru_lambda,
              w_branch_attn, w_branch_lru, w_out, w_mlp_up, w_mlp_down):
    xp, xs = x_prompt, x_sample
    bp = xp.shape[0]
    kp_l, vp_l, cp_l, hp_l, ks_l, vs_l, cs_l, hs_l = [], [], [], [], [], [], [], []
    for l in range(DEPTH):
        lam_init = 0.8 - 0.6 * math.exp(-0.3 * l)
        lw = (norm_mix[l], norm_mlp[l], w_in[l], lambda_q[l], lambda_k[l], head_gain[l],
              conv_w[l], conv_b[l], w_rgate[l], b_rgate[l], w_igate[l], b_igate[l], lru_lambda[l],
              w_branch_attn[l], w_branch_lru[l], w_out[l], w_mlp_up[l], w_mlp_down[l], lam_init)
        conv0 = jnp.zeros((bp, CONV_WIDTH - 1, LRU_WIDTH), xp.dtype)
        h0 = jnp.zeros((bp, LRU_WIDTH), xp.dtype)
        xp, kp, vp, cp, hp = _layer(xp, conv0, h0, _attend_prompt, *lw)
        attend_s = functools.partial(_attend_sample, cache_k[l], cache_v[l])
        xs, kn, vn, cn, hn = _layer(xs, state_conv[l], state_lru[l], attend_s, *lw)
        kp_l.append(kp); vp_l.append(vp); cp_l.append(cp); hp_l.append(hp)
        ks_l.append(kn); vs_l.append(vn); cs_l.append(cn); hs_l.append(hn)
    y_prompt = _rms_norm(xp, norm_final)
    y_sample = _rms_norm(xs, norm_final)
    k_prompt = jnp.stack(kp_l, axis=0)
    v_prompt = jnp.stack(vp_l, axis=0)
    conv_prompt = jnp.stack(cp_l, axis=0)
    lru_prompt = jnp.stack(hp_l, axis=0)
    k_sample = jnp.stack(ks_l, axis=0)
    v_sample = jnp.stack(vs_l, axis=0)
    conv_sample = jnp.stack(cs_l, axis=0)
    lru_sample = jnp.stack(hs_l, axis=0)
    return (y_prompt, y_sample, k_prompt, v_prompt, conv_prompt, lru_prompt,
            k_sample, v_sample, conv_sample, lru_sample)
```

```cpp
#include <hip/hip_runtime.h>
#include <hip/hip_cooperative_groups.h>
#include <cstdio>
#include <cstdint>
namespace cg = cooperative_groups;
namespace pg8 {
#define PG8_LAS __attribute__((address_space(3)))
typedef unsigned short bf16_t;
typedef short bf16x8 __attribute__((ext_vector_type(8)));
typedef float f32x4 __attribute__((ext_vector_type(4)));
typedef unsigned u32x4 __attribute__((ext_vector_type(4)));
constexpr int BM = 256, BK = 64, HALF = 128, HTB = HALF * BK * 2  , STAGE_BYTES = 8 * HTB, NXCD = 8, WGM = 8;

__host__ __device__ __forceinline__ int lds_byte(int r, int c) { const int st = (r >> 4) * 2 + (c >> 5), rr = r & 15, cc = c & 31, ob = rr * 64 + cc * 2; return st * 1024 + (ob ^ (((ob >> 9) & 1) << 5)); }
__host__ __device__ __forceinline__ void stage_rc(int b, int& R, int& C) { const int st = b / 1024, sb = b % 1024, swz = sb ^ (((sb >> 9) & 1) << 5); R = (st >> 1) * 16 + swz / 64; C = (st & 1) * 32 + (swz % 64) / 2; }
__host__ __device__ __forceinline__ int perm32(int rho) { const int n = rho >> 4, i = rho & 15; return 8 * (i >> 2) + 4 * n + (i & 3); }

struct Unit { int pm, pn, kc; };
struct Gemm { const bf16_t* A; const bf16_t* Bt; int M, N, K, ld; };

struct StaticOrder {
    int nM, nN, nwg, G, c;
    __host__ __device__ void init(int M, int N, int G_, int c_) { nM = M / BM; nN = N / BM; nwg = nM * nN; G = G_; c = c_; }
    __host__ __device__ bool next(int i, Unit& u) const {
        const long L = (long)i * G + c; if (L >= nwg) return false;
        int wgid = (int)L; { const int q = nwg / NXCD, r = nwg % NXCD, xcd = wgid % NXCD, off = wgid / NXCD; wgid = (xcd < r ? xcd * (q + 1) : r * (q + 1) + (xcd - r) * q) + off; }
        const int nig = WGM * nN, gid = wgid / nig, fm = gid * WGM, gsz = (nM - fm) < WGM ? (nM - fm) : WGM;
        u.pm = fm + ((wgid % nig) % gsz); u.pn = (wgid % nig) / gsz; u.kc = 0; return true;
    }
    __device__ __forceinline__ void a_ready(const Unit&) const {}
    __device__ __forceinline__ void done(const Unit&) const {}
};

template <class Epi, class Sched, bool ALIGN_EPI = false, bool SP2 = false>
__device__ __forceinline__ void gemm_phase(PG8_LAS unsigned char* lds, const Gemm g, const Sched& S, const Epi& E) {
    const int tid = threadIdx.x, wid = __builtin_amdgcn_readfirstlane(tid >> 6), lane = tid & 63, wr = wid >> 2, wc = wid & 3, fr = lane & 15, fq = lane >> 4;
    const int K = g.ld, nt = g.K / BK; const size_t kcb = (size_t)g.K * 2;
    unsigned voffA[2], voffB[2];
#pragma unroll
    for (int i = 0; i < 2; ++i) { int R, C; stage_rc(tid * 16 + i * 8192, R, C); const int Rb = Epi::PERM ? ((R & ~31) + perm32(R & 31)) : R;
        voffA[i] = (unsigned)(R * K + C) * 2u; voffB[i] = (unsigned)(Rb * K + C) * 2u; }
    const size_t kstep = (size_t)(BK * 2);
    const size_t hstep = (size_t)HALF * K * 2;
    const size_t tstep = 2 * hstep;
    const unsigned ldsw = (unsigned)wid * 1024u;
    const int aoff = lds_byte(wr * 64 + fr, fq * 8), boff = lds_byte(wc * 32 + fr, fq * 8);
#define PG8_SA(b, h) (((b) * 2 + (h)) * HTB)
#define PG8_SB(b, h) ((4 + (b) * 2 + (h)) * HTB)
#define PG8_STAGE(bufoff, gbase, voff) do { _Pragma("unroll") for (int _i = 0; _i < 2; ++_i) \
        __builtin_amdgcn_global_load_lds((const unsigned*)((const char*)(gbase) + (voff)[_i]), (PG8_LAS unsigned*)(lds + (bufoff) + ldsw + _i * 8192), 16, 0, 0); } while (0)
#define PG8_LDA(dst, b, h) do { _Pragma("unroll") for (int m = 0; m < 4; ++m) _Pragma("unroll") for (int k = 0; k < 2; ++k) dst[m][k] = *(const PG8_LAS bf16x8*)(lds + PG8_SA(b, h) + aoff + m * 2048 + k * 1024); } while (0)
#define PG8_LDB(dst, b, h) do { _Pragma("unroll") for (int n = 0; n < 2; ++n) _Pragma("unroll") for (int k = 0; k < 2; ++k) dst[n][k] = *(const PG8_LAS bf16x8*)(lds + PG8_SB(b, h) + boff + n * 2048 + k * 1024); } while (0)
#define PG8_MMA(ai, bj, At, Bt) do { __builtin_amdgcn_s_setprio(1); _Pragma("unroll") for (int m = 0; m < 4; ++m) _Pragma("unroll") for (int n = 0; n < 2; ++n) _Pragma("unroll") for (int k = 0; k < 2; ++k) \
        acc[ai][bj][m][n] = __builtin_amdgcn_mfma_f32_16x16x32_bf16(Bt[n][k], At[m][k], acc[ai][bj][m][n], 0, 0, 0); __builtin_amdgcn_s_setprio(0); } while (0)
#define PG8_WAIT_V(n) asm volatile("s_waitcnt vmcnt(" #n ")" ::: "memory")
#define PG8_WAIT_L(n) asm volatile("s_waitcnt lgkmcnt(" #n ")" ::: "memory")
#define PG8_BAR __builtin_amdgcn_s_barrier()
#define PG8_SCHED __builtin_amdgcn_sched_barrier(0)
    Unit cur, nxt; int ui = 0;
    if (!S.next(0, cur)) return;
    f32x4 acc[2][2][4][2];
#pragma unroll
    for (int a = 0; a < 2; ++a)
#pragma unroll
        for (int b = 0; b < 2; ++b)
#pragma unroll
            for (int m = 0; m < 4; ++m)
#pragma unroll
                for (int n = 0; n < 2; ++n) acc[a][b][m][n] = (f32x4){0.f, 0.f, 0.f, 0.f};
    bf16x8 At[4][2], B0[2][2], B1[2][2];
    const char* cA = (const char*)g.A + (size_t)cur.pm * tstep + (size_t)cur.kc * kcb; const char* cB = (const char*)g.Bt + (size_t)cur.pn * tstep + (size_t)cur.kc * kcb;
    S.a_ready(cur);
    if constexpr (SP2) {
        PG8_STAGE(PG8_SB(0, 0), cB, voffB); PG8_STAGE(PG8_SB(0, 1), cB + hstep, voffB); PG8_STAGE(PG8_SA(0, 0), cA, voffA); PG8_STAGE(PG8_SA(0, 1), cA + hstep, voffA);
        if (wr == 1) PG8_BAR;
        PG8_WAIT_V(2); PG8_BAR;
        PG8_STAGE(PG8_SB(1, 0), cB + kstep, voffB); PG8_STAGE(PG8_SA(1, 0), cA + kstep, voffA); PG8_STAGE(PG8_SB(1, 1), cB + hstep + kstep, voffB);
        PG8_WAIT_V(6); PG8_BAR;
    } else {
        PG8_STAGE(PG8_SB(0, 0), cB, voffB); PG8_STAGE(PG8_SA(0, 0), cA, voffA); PG8_STAGE(PG8_SB(0, 1), cB + hstep, voffB); PG8_STAGE(PG8_SA(0, 1), cA + hstep, voffA);
        if (wr == 1) PG8_BAR;
        PG8_WAIT_V(4); PG8_BAR;
        PG8_STAGE(PG8_SB(1, 0), cB + kstep, voffB); PG8_STAGE(PG8_SA(1, 0), cA + kstep, voffA); PG8_STAGE(PG8_SB(1, 1), cB + hstep + kstep, voffB);
        PG8_WAIT_V(6); PG8_BAR;
    }
    for (;;) {
        const bool has_next = S.next(ui + 1, nxt);
        const char* nA = has_next ? (const char*)g.A + (size_t)nxt.pm * tstep + (size_t)nxt.kc * kcb : cA; const char* nB = has_next ? (const char*)g.Bt + (size_t)nxt.pn * tstep + (size_t)nxt.kc * kcb : cB;
        for (int t = 0; t < nt; t += 2) {
            const bool last = (t == nt - 2);
            const char* a1 = cA + (size_t)(t + 1) * kstep;
            const char* a2 = last ? nA : cA + (size_t)(t + 2) * kstep; const char* b2 = last ? nB : cB + (size_t)(t + 2) * kstep;
            const char* a3 = a2 + kstep; const char* b3 = b2 + kstep;
            if (last && has_next) S.a_ready(nxt);
            if constexpr (SP2) {
            PG8_LDB(B0, 0, 0); PG8_LDB(B1, 0, 1); PG8_SCHED; PG8_LDA(At, 0, 0); PG8_STAGE(PG8_SA(1, 1), a1 + hstep, voffA);
            PG8_WAIT_V(8); PG8_WAIT_L(0); PG8_BAR; PG8_MMA(0, 0, At, B0); PG8_MMA(0, 1, At, B1); PG8_BAR; PG8_SCHED;
            PG8_LDA(At, 0, 1); PG8_STAGE(PG8_SB(0, 0), b2, voffB); PG8_STAGE(PG8_SB(0, 1), b2 + hstep, voffB); PG8_STAGE(PG8_SA(0, 0), a2, voffA);
            PG8_WAIT_V(8); PG8_WAIT_L(0); PG8_BAR; PG8_MMA(1, 0, At, B0); PG8_MMA(1, 1, At, B1); PG8_BAR; PG8_SCHED;
            PG8_LDB(B0, 1, 0); PG8_LDB(B1, 1, 1); PG8_SCHED; PG8_LDA(At, 1, 0); PG8_STAGE(PG8_SA(0, 1), a2 + hstep, voffA);
            PG8_WAIT_V(8); PG8_WAIT_L(0); PG8_BAR; PG8_MMA(0, 0, At, B0); PG8_MMA(0, 1, At, B1); PG8_BAR; PG8_SCHED;
            PG8_LDA(At, 1, 1); PG8_STAGE(PG8_SB(1, 0), b3, voffB); PG8_STAGE(PG8_SB(1, 1), b3 + hstep, voffB); PG8_STAGE(PG8_SA(1, 0), a3, voffA);
            PG8_WAIT_V(8); PG8_WAIT_L(0); PG8_BAR; PG8_MMA(1, 0, At, B0); PG8_MMA(1, 1, At, B1); PG8_BAR; PG8_SCHED;
            } else {
            PG8_LDB(B0, 0, 0); PG8_SCHED; PG8_LDA(At, 0, 0); PG8_STAGE(PG8_SA(1, 1), a1 + hstep, voffA);
            PG8_WAIT_L(8); PG8_BAR; PG8_WAIT_L(0); PG8_MMA(0, 0, At, B0); PG8_BAR; PG8_SCHED;
            PG8_LDB(B1, 0, 1); PG8_STAGE(PG8_SB(0, 0), b2, voffB);
            PG8_BAR; PG8_WAIT_L(0); PG8_MMA(0, 1, At, B1); PG8_BAR;
            PG8_LDA(At, 0, 1); PG8_STAGE(PG8_SA(0, 0), a2, voffA);
            PG8_BAR; PG8_WAIT_L(0); PG8_MMA(1, 0, At, B0); PG8_BAR; PG8_SCHED;
            PG8_STAGE(PG8_SB(0, 1), b2 + hstep, voffB);
            PG8_WAIT_V(6); PG8_BAR; PG8_MMA(1, 1, At, B1); PG8_BAR;
            PG8_LDB(B0, 1, 0); PG8_SCHED; PG8_LDA(At, 1, 0); PG8_STAGE(PG8_SA(0, 1), a2 + hstep, voffA);
            PG8_WAIT_L(8); PG8_BAR; PG8_WAIT_L(0); PG8_MMA(0, 0, At, B0); PG8_BAR; PG8_SCHED;
            PG8_LDB(B1, 1, 1); PG8_STAGE(PG8_SB(1, 0), b3, voffB);
            PG8_BAR; PG8_WAIT_L(0); PG8_MMA(0, 1, At, B1); PG8_BAR;
            PG8_LDA(At, 1, 1); PG8_STAGE(PG8_SA(1, 0), a3, voffA);
            PG8_BAR; PG8_WAIT_L(0); PG8_MMA(1, 0, At, B0); PG8_BAR; PG8_SCHED;
            PG8_STAGE(PG8_SB(1, 1), b3 + hstep, voffB);
            PG8_WAIT_V(6); PG8_BAR; PG8_MMA(1, 1, At, B1); PG8_BAR;
            }
        }
        if constexpr (ALIGN_EPI) { if (wr == 0) PG8_BAR; }
        if constexpr (!Epi::AFTER_DRAIN) { E(acc, cur, wr, wc, fr, fq); S.done(cur); }
        if (!has_next) break;
#pragma unroll
        for (int a = 0; a < 2; ++a)
#pragma unroll
            for (int b = 0; b < 2; ++b)
#pragma unroll
                for (int m = 0; m < 4; ++m)
#pragma unroll
                    for (int n = 0; n < 2; ++n) acc[a][b][m][n] = (f32x4){0.f, 0.f, 0.f, 0.f};
        cur = nxt; cA = nA; cB = nB; ++ui;
        if constexpr (ALIGN_EPI) { if (wr == 1) PG8_BAR; }
    }
    PG8_WAIT_V(0);
    if constexpr (!ALIGN_EPI) { if (wr == 0) PG8_BAR; }
    PG8_BAR;
    if constexpr (Epi::AFTER_DRAIN) { E.fused(acc, cur, wr, wc, fr, fq, lds, wid, lane); S.done(cur); }
#undef PG8_SA
#undef PG8_SB
#undef PG8_STAGE
#undef PG8_LDA
#undef PG8_LDB
#undef PG8_MMA
#undef PG8_WAIT_V
#undef PG8_WAIT_L
#undef PG8_BAR
#undef PG8_SCHED
}
}

#define LAS __attribute__((address_space(3)))
typedef unsigned short bf16_t;
typedef short bf16x8 __attribute__((ext_vector_type(8)));
typedef short s16x4 __attribute__((ext_vector_type(4)));
typedef float f32x4 __attribute__((ext_vector_type(4)));
typedef float f32x16 __attribute__((ext_vector_type(16)));
typedef unsigned u32x4 __attribute__((ext_vector_type(4)));
typedef unsigned u32x2 __attribute__((ext_vector_type(2)));
typedef float f32x2_t __attribute__((ext_vector_type(2)));
typedef __bf16 bf16x2_t __attribute__((ext_vector_type(2)));

constexpr int T = 34816, TP = 32768, DM = 1024, NIN = 7168, FF = 4096, SEQP = 8192;
constexpr float EPS = 1e-6f;
constexpr float QSCALE = 0.125f * 1.4426950408889634f;
constexpr size_t O_Y = 0, O_KP = 35651584, O_VP = 69206016, O_CP = 102760448, O_LP = 102772736, O_KS = 102776832, O_VS = 104873984, O_CS = 106971136, O_LS = 107069440;
constexpr size_t SLOT = (size_t)T * 1024 * 2;
constexpr size_t WS_WIN = 0, WS_WBA = 14680064, WS_WBL = WS_WBA + 2097152, WS_WO = WS_WBL + 2097152, WS_WUP = WS_WO + 2097152, WS_WDN = WS_WUP + 8388608,
                 WS_WR = WS_WDN + 8388608, WS_WI = WS_WR + 131072, WS_AGG = WS_WI + 131072, WS_RSS = WS_AGG + 4194304, WS_CTL = WS_RSS + (size_t)34816 * 64, WS_CARRY = WS_CTL + 256, WS_XB = WS_CARRY + 2097152, WS_SLOT0 = 50331648;
static_assert(WS_XB + 16384 <= WS_SLOT0, "ws map");
constexpr size_t WS_END = WS_SLOT0 + 6 * SLOT;
constexpr int LDS_BYTES = 147456;
#ifndef PROBE_FLAGS
#define PROBE_FLAGS 0
#endif
#ifndef REPMASK
#define REPMASK 0
#endif
#define REPN(k) ((((REPMASK) >> (k)) & 1) ? 2 : 1)

struct Args {
    const float *x_prompt, *x_sample, *cache_k, *cache_v, *state_conv, *state_lru, *norm_mix, *norm_mlp, *norm_final, *w_in, *lambda_q, *lambda_k, *head_gain,
        *conv_w, *conv_b, *w_rgate, *b_rgate, *w_igate, *b_igate, *lru_lambda, *w_ba, *w_bl, *w_o, *w_up, *w_down;
    float* out; unsigned char* ws; int ph_lo, ph_hi, flags, pad;
};

__device__ __forceinline__ unsigned pk2(float lo, float hi) { f32x2_t v = {lo, hi}; bf16x2_t b = __builtin_convertvector(v, bf16x2_t); return __builtin_bit_cast(unsigned, b); }
__device__ __forceinline__ bf16_t f2bf(float f) { __bf16 b = (__bf16)f; return __builtin_bit_cast(unsigned short, b); }
__device__ __forceinline__ float bf2f(bf16_t u) { return __uint_as_float(((unsigned)u) << 16); }
__device__ __forceinline__ float bflo(unsigned u) { return __uint_as_float(u << 16); }
__device__ __forceinline__ float bfhi(unsigned u) { return __uint_as_float(u & 0xffff0000u); }
__device__ __forceinline__ float fsigmoid(float x) { return __builtin_amdgcn_rcpf(1.0f + __builtin_amdgcn_exp2f(-1.4426950408889634f * x)); }
__device__ __forceinline__ float gelu_tanh(float x) { const float y = 0.7978845608028654f * (x + 0.044715f * x * x * x); return x * fsigmoid(2.0f * y); }
__device__ __forceinline__ u32x4 pack8(const f32x4& a, const f32x4& b) { u32x4 w; w.x = pk2(a[0], a[1]); w.y = pk2(a[2], a[3]); w.z = pk2(b[0], b[1]); w.w = pk2(b[2], b[3]); return w; }
__device__ __forceinline__ int crow(int r, int hi) { return (r & 3) + 8 * (r >> 2) + 4 * hi; }
#define LDS_FENCE() asm volatile("s_waitcnt lgkmcnt(0)" ::: "memory")
#define MFMA32(a, b, c) __builtin_amdgcn_mfma_f32_32x32x16_bf16((a), (b), (c), 0, 0, 0)

using pg8::Unit;
#define EPI_LOOP(...) _Pragma("unroll") for (int ai = 0; ai < 2; ++ai) _Pragma("unroll") for (int m = 0; m < 4; ++m) { const int row = rbase + ai * 128 + m * 16; \
    _Pragma("unroll") for (int bj = 0; bj < 2; ++bj) { const int col = cbase + bj * 128; const f32x4 v0 = acc[ai][bj][m][0], v1 = acc[ai][bj][m][1]; __VA_ARGS__ } }

struct EpiIn {
    static constexpr bool PERM = true, AFTER_DRAIN = false;
    bf16_t *Q, *Kb, *VT, *XL, *GG, *GA, *GB; float* out;
    __device__ __forceinline__ void operator()(const f32x4 (&acc)[2][2][4][2], const Unit& u, int wr, int wc, int fr, int fq) const {
        const int sec = u.pn >> 2;
        const int cbase = (u.pn & 3) * 256 + wc * 32 + 8 * fq;
        const int rbase = u.pm * 256 + wr * 64 + fr;
        const bool prompt = u.pm < 128;
        if (sec == 0) {
            EPI_LOOP({ *(u32x4*)(Q + (size_t)row * 1024 + col) = pack8(v0 * QSCALE, v1 * QSCALE); })
        } else if (sec == 1) {
            float* ko = prompt ? out + O_KP : out + O_KS - (size_t)TP * 1024;
            EPI_LOOP({ float* o = ko + (size_t)row * 1024 + col; *(f32x4*)o = v0; *(f32x4*)(o + 4) = v1; *(u32x4*)(Kb + (size_t)row * 1024 + col) = pack8(v0, v1); })
        } else if (sec == 2) {
            float* vo = prompt ? out + O_VP : out + O_VS - (size_t)TP * 1024;
            EPI_LOOP({ float* o = vo + (size_t)row * 1024 + col; *(f32x4*)o = v0; *(f32x4*)(o + 4) = v1; *(u32x4*)(VT + (size_t)row * 1024 + col) = pack8(v0, v1); })
        } else if (sec == 3) {
            EPI_LOOP({ *(u32x4*)(XL + (size_t)row * 1024 + col) = pack8(v0, v1);
                if (prompt) { const int pos = row & (SEQP - 1); if (pos >= SEQP - 3) { float* o = out + O_CP + (size_t)((row >> 13) * 3 + pos - (SEQP - 3)) * 1024 + col; *(f32x4*)o = v0; *(f32x4*)(o + 4) = v1; } }
                else { const int rs = row - TP; const int pos = rs & 63; if (pos >= 61) { float* o = out + O_CS + (size_t)((rs >> 6) * 3 + pos - 61) * 1024 + col; *(f32x4*)o = v0; *(f32x4*)(o + 4) = v1; } } })
        } else if (sec == 4) {
            EPI_LOOP({ f32x4 a, b; _Pragma("unroll") for (int j = 0; j < 4; ++j) { a[j] = gelu_tanh(v0[j]); b[j] = gelu_tanh(v1[j]); }
                *(u32x4*)(GG + (size_t)row * 1024 + col) = pack8(a, b); })
        } else {
            bf16_t* G = (sec == 5) ? GA : GB;
            EPI_LOOP({ f32x4 a, b; _Pragma("unroll") for (int j = 0; j < 4; ++j) { a[j] = fsigmoid(v0[j]); b[j] = fsigmoid(v1[j]); }
                *(u32x4*)(G + (size_t)row * 1024 + col) = pack8(a, b); })
        }
    }
};
__device__ __forceinline__ void unpack8(const u32x4 w, f32x4& a, f32x4& b) { a[0] = bflo(w.x); a[1] = bfhi(w.x); a[2] = bflo(w.y); a[3] = bfhi(w.y); b[0] = bflo(w.z); b[1] = bfhi(w.z); b[2] = bflo(w.w); b[3] = bfhi(w.w); }
struct EpiM1 {
    static constexpr bool PERM = true, AFTER_DRAIN = false;
    const bf16_t* G; bf16_t* O;
    __device__ __forceinline__ void operator()(const f32x4 (&acc)[2][2][4][2], const Unit& u, int wr, int wc, int fr, int fq) const {
        const int cbase = u.pn * 256 + wc * 32 + 8 * fq, rbase = u.pm * 256 + wr * 64 + fr;
        EPI_LOOP({ f32x4 g0, g1; unpack8(*(const u32x4*)(G + (size_t)row * 1024 + col), g0, g1); *(u32x4*)(O + (size_t)row * 1024 + col) = pack8(g0 * v0, g1 * v1); })
    }
};
struct EpiM2 {
    static constexpr bool PERM = true, AFTER_DRAIN = false;
    const bf16_t* G; const bf16_t* Tm; bf16_t* O;
    __device__ __forceinline__ void operator()(const f32x4 (&acc)[2][2][4][2], const Unit& u, int wr, int wc, int fr, int fq) const {
        const int cbase = u.pn * 256 + wc * 32 + 8 * fq, rbase = u.pm * 256 + wr * 64 + fr;
        EPI_LOOP({ f32x4 g0, g1, t0, t1; unpack8(*(const u32x4*)(G + (size_t)row * 1024 + col), g0, g1); unpack8(*(const u32x4*)(Tm + (size_t)row * 1024 + col), t0, t1);
            *(u32x4*)(O + (size_t)row * 1024 + col) = pack8(t0 + g0 * v0, t1 + g1 * v1); })
    }
};
struct EpiO {
    static constexpr bool PERM = true, AFTER_DRAIN = false;
    const float *xp, *xs; float* H; bf16_t* HB; float* RSS;
    __device__ __forceinline__ void operator()(const f32x4 (&acc)[2][2][4][2], const Unit& u, int wr, int wc, int fr, int fq) const {
        const int cbase = u.pn * 256 + wc * 32 + 8 * fq, rbase = u.pm * 256 + wr * 64 + fr;
        const float* xb = (u.pm < 128) ? xp : xs - (size_t)TP * 1024;
#pragma unroll
        for (int ai = 0; ai < 2; ++ai)
#pragma unroll
            for (int m = 0; m < 4; ++m) { const int row = rbase + ai * 128 + m * 16; float ss = 0.f;
#pragma unroll
                for (int bj = 0; bj < 2; ++bj) { const int col = cbase + bj * 128; const float* xr = xb + (size_t)row * 1024 + col;
                    const f32x4 h0 = *(const f32x4*)xr + acc[ai][bj][m][0], h1 = *(const f32x4*)(xr + 4) + acc[ai][bj][m][1];
                    float* o = H + (size_t)row * 1024 + col; *(f32x4*)o = h0; *(f32x4*)(o + 4) = h1;
                    *(u32x4*)(HB + (size_t)row * 1024 + col) = pack8(h0, h1);
                    ss += (h0[0] * h0[0] + h0[1] * h0[1]) + (h0[2] * h0[2] + h0[3] * h0[3]) + (h1[0] * h1[0] + h1[1] * h1[1]) + (h1[2] * h1[2] + h1[3] * h1[3]); }
                ss += __shfl_xor(ss, 16); ss += __shfl_xor(ss, 32);
                if (fq == 0) RSS[(size_t)row * 16 + u.pn * 4 + wc] = ss; }
    }
};
struct EpiUp {
    static constexpr bool PERM = true, AFTER_DRAIN = false;
    const float* RSS; bf16_t* UP;
    __device__ __forceinline__ void operator()(const f32x4 (&acc)[2][2][4][2], const Unit& u, int wr, int wc, int fr, int fq) const {
        const int cbase = u.pn * 256 + wc * 32 + 8 * fq, rbase = u.pm * 256 + wr * 64 + fr;
#pragma unroll
        for (int ai = 0; ai < 2; ++ai)
#pragma unroll
            for (int m = 0; m < 4; ++m) { const int row = rbase + ai * 128 + m * 16;
                const f32x4* rp = (const f32x4*)(RSS + (size_t)row * 16); const f32x4 s = (rp[0] + rp[1]) + (rp[2] + rp[3]);
                const float rstd = __builtin_amdgcn_rsqf(((s[0] + s[1]) + (s[2] + s[3])) * (1.0f / 1024.0f) + EPS);
#pragma unroll
                for (int bj = 0; bj < 2; ++bj) { const int col = cbase + bj * 128; f32x4 a = acc[ai][bj][m][0] * rstd, b = acc[ai][bj][m][1] * rstd;
#pragma unroll
                    for (int j = 0; j < 4; ++j) { a[j] = fmaxf(a[j], 0.f); a[j] *= a[j]; b[j] = fmaxf(b[j], 0.f); b[j] *= b[j]; }
                    *(u32x4*)(UP + (size_t)row * FF + col) = pack8(a, b); } }
    }
};
struct EpiDown {
    static constexpr bool PERM = true, AFTER_DRAIN = false;
    float* H;
    __device__ __forceinline__ void operator()(const f32x4 (&acc)[2][2][4][2], const Unit& u, int wr, int wc, int fr, int fq) const {
        const int cbase = u.pn * 256 + wc * 32 + 8 * fq, rbase = u.pm * 256 + wr * 64 + fr;
        EPI_LOOP({ float* o = H + (size_t)row * 1024 + col; const f32x4 h0 = *(const f32x4*)o + v0, h1 = *(const f32x4*)(o + 4) + v1; *(f32x4*)o = h0; *(f32x4*)(o + 4) = h1; })
    }
};

struct EpiPart {
    static constexpr bool PERM = true, AFTER_DRAIN = false;
    float* PART;
    __device__ __forceinline__ void operator()(const f32x4 (&acc)[2][2][4][2], const Unit& u, int wr, int wc, int fr, int fq) const {
        const int cbase = u.pn * 256 + wc * 32 + 8 * fq, rbase = u.pm * 256 + wr * 64 + fr;
        float* pb = PART + (size_t)u.kc * 2048 * 1024;
        EPI_LOOP({ float* o = pb + (size_t)(row - TP) * 1024 + col; *(f32x4*)o = v0; *(f32x4*)(o + 4) = v1; })
    }
};
struct SplitOrder {
    int G, c;
    __device__ __forceinline__ bool next(int i, Unit& u) const { const int L = i * G + c; if (L >= 256) return false; u.pm = 128 + (L >> 5); const int r = L & 31; u.pn = r >> 3; u.kc = r & 7; return true; }
    __device__ __forceinline__ void a_ready(const Unit&) const {}
    __device__ __forceinline__ void done(const Unit&) const {}
};
__device__ __forceinline__ float wave_sum(float v) {
#pragma unroll
    for (int o = 1; o < 64; o <<= 1) v += __shfl_xor(v, o);
    return v;
}
__device__ __forceinline__ void transpose_item(const float* __restrict__ W, int K, int N, const float* __restrict__ kscale, bf16_t* WT, LAS float* scr, int item, int lane) {
    const int nblk = N / 32, kb = item / nblk, nb = item % nblk, k0 = 64 * kb, n0 = 32 * nb;
#pragma unroll 8
    for (int i = 0; i < 32; ++i) { const int kk = 2 * i + (lane >> 5); float v = W[(size_t)(k0 + kk) * N + n0 + (lane & 31)]; if (kscale) v *= kscale[k0 + kk]; scr[kk * 33 + (lane & 31)] = v; }
    LDS_FENCE();
    const int c = lane & 7;
#pragma unroll
    for (int j = 0; j < 4; ++j) { const int n = (lane >> 3) + 8 * j; const LAS float* s = scr + (8 * c) * 33 + n;
        u32x4 o; o.x = pk2(s[0 * 33], s[1 * 33]); o.y = pk2(s[2 * 33], s[3 * 33]); o.z = pk2(s[4 * 33], s[5 * 33]); o.w = pk2(s[6 * 33], s[7 * 33]);
        *(u32x4*)(WT + (size_t)(n0 + n) * K + k0 + 8 * c) = o; }
    LDS_FENCE();
}

struct LruP { const bf16_t *XL, *GG, *WRt, *WIt; bf16_t* BO; bf16_t *LA, *U; float* AGG; const float* CARRY; const float *conv_w, *conv_b, *b_r, *b_i, *lam, *state_conv, *state_lru; float* out; };
template <bool FINAL>
__device__ __forceinline__ void lru_item(const LruP& p, LAS char* scr, int tl, int n, int lane) {
    const int l31 = lane & 31, hi = lane >> 5;
    const bool samp = tl >= 512; const int bs = tl - 512, c = tl & 127, bp = tl >> 7;
    const size_t tok0 = (size_t)tl * 64;
    LAS bf16_t* sx = (LAS bf16_t*)scr;
    const unsigned lvoff = (unsigned)((4 * hi * 1024 + l31) * 2);
    {
        const int ch = n * 64 + lane;
        const float w0 = p.conv_w[ch], w1 = p.conv_w[1024 + ch], w2 = p.conv_w[2048 + ch], w3 = p.conv_w[3072 + ch], cb = p.conv_b[ch];
        float x0, x1, x2;
        if (samp) { x0 = p.state_conv[(size_t)(bs * 3 + 0) * 1024 + ch]; x1 = p.state_conv[(size_t)(bs * 3 + 1) * 1024 + ch]; x2 = p.state_conv[(size_t)(bs * 3 + 2) * 1024 + ch]; }
        else if (c == 0) { x0 = 0.f; x1 = 0.f; x2 = 0.f; }
        else { x0 = bf2f(p.XL[(tok0 - 3) * 1024 + ch]); x1 = bf2f(p.XL[(tok0 - 2) * 1024 + ch]); x2 = bf2f(p.XL[(tok0 - 1) * 1024 + ch]); }
        const unsigned l2 = (unsigned)lane * 2u;
#pragma unroll 16
        for (int t = 0; t < 64; ++t) { const float x3 = bf2f(*(const bf16_t*)((const char*)(p.XL + (tok0 + t) * 1024 + n * 64) + l2)); const float xc = cb + w0 * x0 + w1 * x1 + w2 * x2 + w3 * x3; sx[t * 72 + lane] = f2bf(xc); x0 = x1; x1 = x2; x2 = x3; }
    }
    LDS_FENCE();
    for (int nt = 0; nt < 2; ++nt) {
        const int chd = n * 64 + 32 * nt + l31;
        f32x16 R[2], I[2];
#pragma unroll
        for (int r = 0; r < 16; ++r) { R[0][r] = 0.f; R[1][r] = 0.f; I[0][r] = 0.f; I[1][r] = 0.f; }
#pragma unroll
        for (int kk = 0; kk < 4; ++kk) {
            const bf16x8 br = *(const bf16x8*)(p.WRt + (size_t)chd * 64 + 16 * kk + 8 * hi);
            const bf16x8 bi = *(const bf16x8*)(p.WIt + (size_t)chd * 64 + 16 * kk + 8 * hi);
#pragma unroll
            for (int mt = 0; mt < 2; ++mt) { const bf16x8 a = *(const LAS bf16x8*)(scr + (32 * mt + l31) * 144 + (16 * kk + 8 * hi) * 2); R[mt] = MFMA32(a, br, R[mt]); I[mt] = MFMA32(a, bi, I[mt]); }
        }
        const float brv = p.b_r[chd], biv = p.b_i[chd];
        const float sp8 = -8.0f * log1pf(__expf(-p.lam[chd]));
#pragma unroll
        for (int mt = 0; mt < 2; ++mt)
#pragma unroll
            for (int r = 0; r < 16; ++r) { const int t = 32 * mt + crow(r, hi); const float xcv = bf2f(sx[t * 72 + 32 * nt + l31]);
                const float rg = fsigmoid(R[mt][r] + brv), ig = fsigmoid(I[mt][r] + biv);
                const bf16_t lab = f2bf(rg * sp8); const float la = bf2f(lab), av = __builtin_amdgcn_exp2f(la * 1.4426950408889634f), x2 = 2.0f * la;
                const float ser = -x2 * (1.0f + x2 * (0.5f + x2 * (0.16666667f + x2 * (0.041666668f + x2 * 0.008333334f))));
                const float om = (x2 > -0.25f) ? ser : (1.0f - av * av);
                const bf16_t ub16 = f2bf(__builtin_amdgcn_sqrtf(om) * ig * xcv);
                R[mt][r] = av; I[mt][r] = bf2f(ub16);
                if (!FINAL) { const size_t ub = ((tok0 + 32 * mt + (r & 3) + 8 * (r >> 2)) * 1024 + n * 64 + 32 * nt) * 2;
                    *(bf16_t*)((char*)p.LA + ub + lvoff) = lab; *(bf16_t*)((char*)p.U + ub + lvoff) = ub16; } }
        float oA[8], oH[8], pA[8], pH[8];
#pragma unroll
        for (int gi = 0; gi < 8; ++gi) { float A = 1.f, H = 0.f;
#pragma unroll
            for (int j = 0; j < 4; ++j) { const float a = R[gi >> 2][(gi & 3) * 4 + j]; H = a * H + I[gi >> 2][(gi & 3) * 4 + j]; A *= a; }
            oA[gi] = A; oH[gi] = H; pA[gi] = __shfl_xor(A, 32); pH[gi] = __shfl_xor(H, 32); }
        float h = 0.f;
        if (FINAL) {
            if (samp) h = p.state_lru[(size_t)bs * 1024 + chd];
            else h = p.CARRY[(size_t)tl * 1024 + chd];
        }
        float cin[8], Atot = 1.f;
#pragma unroll
        for (int k = 0; k < 8; ++k) { const float Alo = hi ? pA[k] : oA[k], Hlo = hi ? pH[k] : oH[k], Ahi = hi ? oA[k] : pA[k], Hhi = hi ? oH[k] : pH[k];
            const float hm = Alo * h + Hlo; cin[k] = hi ? hm : h; h = Ahi * hm + Hhi; Atot *= Alo * Ahi; }
        if (!FINAL) { if (hi == 0 && !samp) { p.AGG[(size_t)tl * 2048 + chd] = Atot; p.AGG[(size_t)tl * 2048 + 1024 + chd] = h; } }
        else {
#pragma unroll
            for (int gi = 0; gi < 8; ++gi) { float hh = cin[gi];
#pragma unroll
                for (int j = 0; j < 4; ++j) { const int r = (gi & 3) * 4 + j, mt = gi >> 2; hh = R[mt][r] * hh + I[mt][r]; const size_t ub = ((tok0 + 32 * mt + (r & 3) + 8 * (r >> 2)) * 1024 + n * 64 + 32 * nt) * 2;
                    *(bf16_t*)((char*)p.BO + ub + lvoff) = f2bf(hh * bf2f(*(const bf16_t*)((const char*)p.GG + ub + lvoff))); } }
            if (hi == 0) { if (samp) p.out[O_LS + (size_t)bs * 1024 + chd] = h; else if (c == 127) p.out[O_LP + (size_t)bp * 1024 + chd] = h; }
        }
    }
    LDS_FENCE();
}

__device__ __forceinline__ void lru_final_light(const LruP& p, int tl, int half, int lane) {
    const bool samp = tl >= 512; const int bs = tl - 512, c = tl & 127, bp = tl >> 7; const size_t tok0 = (size_t)tl * 64;
    const int ch0 = half * 512 + lane * 8;
    f32x4 h0, h1;
    { const float* hp = samp ? p.state_lru + (size_t)bs * 1024 + ch0 : p.CARRY + (size_t)tl * 1024 + ch0; h0 = *(const f32x4*)hp; h1 = *(const f32x4*)(hp + 4); }
    const unsigned lo8 = (unsigned)(ch0 * 2);
#pragma unroll 8
    for (int t = 0; t < 64; ++t) { const size_t ub = (tok0 + t) * 2048;
        f32x4 a0, a1, u0, u1, g0, g1;
        unpack8(*(const u32x4*)((const char*)p.LA + ub + lo8), a0, a1); unpack8(*(const u32x4*)((const char*)p.U + ub + lo8), u0, u1); unpack8(*(const u32x4*)((const char*)p.GG + ub + lo8), g0, g1);
#pragma unroll
        for (int j = 0; j < 4; ++j) { h0[j] = __builtin_amdgcn_exp2f(a0[j] * 1.4426950408889634f) * h0[j] + u0[j]; h1[j] = __builtin_amdgcn_exp2f(a1[j] * 1.4426950408889634f) * h1[j] + u1[j]; }
        *(u32x4*)((char*)p.BO + ub + lo8) = pack8(h0 * g0, h1 * g1); }
    float* op = samp ? p.out + O_LS + (size_t)bs * 1024 + ch0 : (c == 127 ? p.out + O_LP + (size_t)bp * 1024 + ch0 : nullptr);
    if (op) { *(f32x4*)op = h0; *(f32x4*)(op + 4) = h1; }
}
constexpr int AT_KB = 16384, AT_BUF = 32768, AT_EXCH = 2 * AT_BUF, AT_WSF = AT_EXCH + 65536;
static_assert(AT_WSF + 2048 <= LDS_BYTES, "attention LDS map");
typedef short v4i16_t __attribute__((ext_vector_type(4)));
struct AttP { const bf16_t *Q, *Kb, *VT; bf16_t* AO; const float *cache_k, *cache_v, *head_gain; int flags; };
template <bool SAMPLE>
__device__ __forceinline__ void attn_unit(const AttP& p, LAS char* lds, int b, int h, int qb, float lam) {
    const int tid = threadIdx.x, lane = tid & 63, l31 = lane & 31, hi = lane >> 5;
    const int w = __builtin_amdgcn_readfirstlane(tid >> 6), c = w >> 2, wq = w & 3;
    const size_t tok0 = SAMPLE ? (size_t)(TP + b * 64) : (size_t)b * SEQP;
    const int q0 = SAMPLE ? 0 : qb * 128;
    const int NT = SAMPLE ? 17 : 2 * qb + 2;
    const bool active = SAMPLE ? (wq < 2) : true;
    const int myNT = SAMPLE ? 17 : (wq < 2 ? NT - 1 : NT);
    LAS float* wsf = (LAS float*)(lds + AT_WSF) + w * 64;
    const int kfo = l31 * 256, kfx = (c * 8 + hi) ^ (l31 & 15);
    const int vq = (lane & 15) >> 2, vfo = (4 * hi + vq) * 256 + ((lane >> 4) & 1) * 32 + (lane & 3) * 8;
    const unsigned aovoff = (unsigned)((4 * hi * 1024 + l31) * 2);
    bf16x8 qf[4];
    { const bf16_t* qp = p.Q + (tok0 + q0 + (active ? wq : 0) * 32 + l31) * 1024 + h * 128 + c * 64 + hi * 8;
#pragma unroll
      for (int d0 = 0; d0 < 4; ++d0) qf[d0] = *(const bf16x8*)(qp + d0 * 16); }
    f32x16 O[4];
#pragma unroll
    for (int dt = 0; dt < 4; ++dt)
#pragma unroll
        for (int r = 0; r < 16; ++r) O[dt][r] = 0.f;
    float mrun = 0.f, lrun = 0.f;
    u32x4 st[4];
    if (!SAMPLE) { st[0] = st[1] = st[2] = st[3] = (u32x4){0u, 0u, 0u, 0u}; }
    const unsigned coff_l = (unsigned)(((tid >> 5) * 1024 + (tid & 31) * 4) * 4);
    unsigned ksrc[2], vsrc[2];
#pragma unroll
    for (int i = 0; i < 2; ++i) { const int row = 4 * (w * 2 + i) + (lane >> 4), chp = lane & 15;
        ksrc[i] = (unsigned)((row * 1024 + (chp ^ (row & 15)) * 8) * 2); vsrc[i] = (unsigned)((row * 1024 + (chp ^ ((row & 3) << 2)) * 8) * 2); }
#define DMA_K(trow_, buf_) do { const char* gk_ = (const char*)(p.Kb + (size_t)(trow_) * 1024 + h * 128); _Pragma("unroll") for (int i = 0; i < 2; ++i) \
            __builtin_amdgcn_global_load_lds((const unsigned*)(gk_ + ksrc[i]), (LAS unsigned*)(lds + (buf_) * AT_BUF + (w * 2 + i) * 1024), 16, 0, 0); } while (0)
#define DMA_V(trow_, buf_) do { const char* gv_ = (const char*)(p.VT + (size_t)(trow_) * 1024 + h * 128); _Pragma("unroll") for (int i = 0; i < 2; ++i) \
            __builtin_amdgcn_global_load_lds((const unsigned*)(gv_ + vsrc[i]), (LAS unsigned*)(lds + (buf_) * AT_BUF + AT_KB + (w * 2 + i) * 1024), 16, 0, 0); } while (0)
#define LOAD_F32(src_, t_) do { _Pragma("unroll") for (int i = 0; i < 4; ++i) { \
            st[i] = *(const u32x4*)((const char*)((src_) + (((size_t)b * 1024 + (t_) * 64 + 16 * i) * 8 + h) * 128) + coff_l); } } while (0)
#define STORE_F32(buf_, boff_, isv_) do { LAS char* kb_ = lds + (buf_) * AT_BUF + (boff_); _Pragma("unroll") for (int i = 0; i < 4; ++i) { const int id = tid + 512 * i; const int row = id >> 5, c4 = id & 31; \
            u32x2 kk; kk.x = pk2(__uint_as_float(st[i][0]), __uint_as_float(st[i][1])); kk.y = pk2(__uint_as_float(st[i][2]), __uint_as_float(st[i][3])); \
            const int sw_ = (isv_) ? ((row & 3) << 2) : (row & 15); \
            *(LAS u32x2*)(kb_ + row * 256 + (((c4 >> 1) ^ sw_) << 4) + (c4 & 1) * 8) = kk; } } while (0)
    if (SAMPLE) { LOAD_F32(p.cache_k, 0); STORE_F32(0, 0, 0); } else { DMA_K(tok0, 0); }
    __syncthreads();
    mrun = 0.f;
    bf16x8 pa0, pa1, pa2, pa3;
    pa0 = pa1 = pa2 = pa3 = (bf16x8){0, 0, 0, 0, 0, 0, 0, 0};
#define VLOAD(dst_, s_) do { _Pragma("unroll") for (int dt = 0; dt < 4; ++dt) { LAS char* vp = vb + vfo + ((dt ^ vq) << 6) + (16 * (s_)) * 256; \
                    const v4i16_t lo_ = __builtin_amdgcn_ds_read_tr16_b64_v4i16((LAS v4i16_t*)vp), hh_ = __builtin_amdgcn_ds_read_tr16_b64_v4i16((LAS v4i16_t*)(vp + 8 * 256)); \
                    dst_[dt] = __builtin_shufflevector(lo_, hh_, 0, 1, 2, 3, 4, 5, 6, 7); } } while (0)
#define PKP(P_, q_) __builtin_bit_cast(bf16x8, (u32x4){pk2(P_[8 * q_ + 0], P_[8 * q_ + 1]), pk2(P_[8 * q_ + 2], P_[8 * q_ + 3]), pk2(P_[8 * q_ + 4], P_[8 * q_ + 5]), pk2(P_[8 * q_ + 6], P_[8 * q_ + 7])})
#define PVMM(pa_, vf_) do { _Pragma("unroll") for (int dt = 0; dt < 4; ++dt) O[dt] = MFMA32(pa_, vf_[dt], O[dt]); } while (0)
#define PV_ALL() do { bf16x8 va[4]; VLOAD(va, 0); PVMM(pa0, va); VLOAD(va, 1); PVMM(pa1, va); VLOAD(va, 2); PVMM(pa2, va); VLOAD(va, 3); PVMM(pa3, va); } while (0)
#define QK_MAX(t_, kb_) \
            const bool maskt = !SAMPLE && ((t_) >= myNT);        \
            f32x16 p0, p1; \
            _Pragma("unroll") for (int r = 0; r < 16; ++r) { p0[r] = 0.f; p1[r] = 0.f; } \
            _Pragma("unroll") for (int d0 = 0; d0 < 4; ++d0) { \
                const bf16x8 k0 = *(const LAS bf16x8*)((kb_) + kfo + ((kfx ^ (d0 << 1)) << 4)); \
                const bf16x8 k1 = *(const LAS bf16x8*)((kb_) + kfo + 8192 + ((kfx ^ (d0 << 1)) << 4)); \
                p0 = MFMA32(k0, qf[d0], p0); p1 = MFMA32(k1, qf[d0], p1); } \
            __builtin_amdgcn_sched_group_barrier(0x100, 4, 0); \
            _Pragma("unroll") for (int i_ = 0; i_ < 2; ++i_) { __builtin_amdgcn_sched_group_barrier(0x008, 1, 0); __builtin_amdgcn_sched_group_barrier(0x100, 2, 0); } \
            __builtin_amdgcn_sched_group_barrier(0x008, 6, 0); \
            float rm = fmaxf(fmaxf(p0[0], p1[0]), p0[1]); \
            _Pragma("unroll") for (int r = 2; r < 16; r += 2) rm = fmaxf(fmaxf(rm, p0[r]), p0[r + 1]); \
            _Pragma("unroll") for (int r = 1; r < 16; r += 2) rm = fmaxf(fmaxf(rm, p1[r]), p1[(r + 1) & 15]); \
            rm = fmaxf(rm, __shfl_xor(rm, 32)) - mrun; \
            if (maskt) rm = 0.f; \
            const bool resc = __any(rm > 8.0f) || (t_) == 0;     \
            float alpha = 1.0f; \
            if (resc) { const float dl = (rm > 8.0f || (t_) == 0) ? rm : 0.f; alpha = __builtin_amdgcn_exp2f(-dl); mrun += dl; lrun *= alpha; } \
            const float sh = maskt ? 1e30f : mrun; \
            _Pragma("unroll") for (int r = 0; r < 16; ++r) { p0[r] -= sh; p1[r] -= sh; } \
            __builtin_amdgcn_sched_barrier(0);
#define O_RESCALE() do { if (resc) { if (hi == 0) wsf[l31] = alpha; LDS_FENCE(); \
                _Pragma("unroll") for (int r = 0; r < 16; ++r) { const float a_ = wsf[crow(r, hi)]; _Pragma("unroll") for (int dt = 0; dt < 4; ++dt) O[dt][r] *= a_; } LDS_FENCE(); } } while (0)
    if (!SAMPLE) { DMA_K(tok0 + 64, 1); DMA_V(tok0, 0); }
    if (active) {
        QK_MAX(0, lds)
        float ls = 0.f;
#pragma unroll
        for (int r = 0; r < 16; ++r) { p0[r] = __builtin_amdgcn_exp2f(p0[r]); p1[r] = __builtin_amdgcn_exp2f(p1[r]); ls += p0[r] + p1[r]; }
        lrun += ls;
        pa0 = PKP(p0, 0); pa1 = PKP(p0, 1); pa2 = PKP(p1, 0); pa3 = PKP(p1, 1);
    }
    if (SAMPLE) { LOAD_F32(p.cache_k, 1); STORE_F32(1, 0, 0); LOAD_F32(p.cache_v, 0); STORE_F32(0, AT_KB, 1); }
    __syncthreads();
    for (int t = 1; t < NT; ++t) {
        const int buf = t & 1;
        if (!SAMPLE) { if (t + 1 < NT) DMA_K(tok0 + (size_t)(t + 1) * 64, buf ^ 1); DMA_V(tok0 + (size_t)t * 64, buf); }
        else { if (t + 1 == 16) DMA_K(tok0, buf ^ 1); if (t == 16) DMA_V(tok0, buf); }
        LAS char* vb = lds + (buf ^ 1) * AT_BUF + AT_KB;
        if (active) {
            QK_MAX(t, lds + buf * AT_BUF)
            float ls = 0.f;
            bf16x8 va[4];
#define EXP8(P_, q_) do { _Pragma("unroll") for (int r = 8 * (q_); r < 8 * (q_) + 8; ++r) { P_[r] = __builtin_amdgcn_exp2f(P_[r]); ls += P_[r]; } } while (0)
            VLOAD(va, 0); EXP8(p0, 0); PVMM(pa0, va); pa0 = PKP(p0, 0);
            VLOAD(va, 1); EXP8(p0, 1); PVMM(pa1, va); pa1 = PKP(p0, 1);
            VLOAD(va, 2); EXP8(p1, 0); PVMM(pa2, va); pa2 = PKP(p1, 0);
            VLOAD(va, 3); EXP8(p1, 1); PVMM(pa3, va); pa3 = PKP(p1, 1);
#undef EXP8
            __builtin_amdgcn_sched_group_barrier(0x100, 8, 0); __builtin_amdgcn_sched_group_barrier(0x002, 8, 0);
#pragma unroll
            for (int i_ = 0; i_ < 8; ++i_) { __builtin_amdgcn_sched_group_barrier(0x008, 1, 0); __builtin_amdgcn_sched_group_barrier(0x100, 2, 0); __builtin_amdgcn_sched_group_barrier(0x002, 5, 0); }
#pragma unroll
            for (int i_ = 0; i_ < 4; ++i_) { __builtin_amdgcn_sched_group_barrier(0x008, 1, 0); __builtin_amdgcn_sched_group_barrier(0x100, 2, 0); __builtin_amdgcn_sched_group_barrier(0x002, 4, 0); }
#pragma unroll
            for (int i_ = 0; i_ < 4; ++i_) { __builtin_amdgcn_sched_group_barrier(0x008, 1, 0); __builtin_amdgcn_sched_group_barrier(0x002, 4, 0); }
            lrun += ls;
            O_RESCALE();
        }
        if (SAMPLE) { if (t + 1 < 16) { LOAD_F32(p.cache_k, t + 1); STORE_F32(buf ^ 1, 0, 0); } if (t < 16) { LOAD_F32(p.cache_v, t); STORE_F32(buf, AT_KB, 1); } }
        __syncthreads();
    }
    if (active) { LAS char* vb = lds + ((NT - 1) & 1) * AT_BUF + AT_KB; PV_ALL(); }
    __syncthreads();
#undef QK_MAX
#undef O_RESCALE
#undef VLOAD
#undef PKP
#undef PVMM
#undef PV_ALL
    if (active) {
        const float lt = lrun + __shfl_xor(lrun, 32);
        const float sc = (c == 0 ? 1.0f : lam) * __builtin_amdgcn_rcpf(lt);
        if (hi == 0) wsf[l31] = sc;
        LDS_FENCE();
#pragma unroll
        for (int r = 0; r < 16; ++r) { const float a = wsf[crow(r, hi)];
#pragma unroll
            for (int dt = 0; dt < 4; ++dt) O[dt][r] *= a; }
        LDS_FENCE();
    }
    LAS float* ex = (LAS float*)(lds + AT_EXCH) + wq * 4096;
    if (active && c == 1) {
#pragma unroll
        for (int dt = 0; dt < 4; ++dt)
#pragma unroll
            for (int r = 0; r < 16; ++r) ex[(dt * 16 + r) * 64 + lane] = O[dt][r];
    }
    __syncthreads();
    if (active && c == 0) {
        float hg[4];
#pragma unroll
        for (int dt = 0; dt < 4; ++dt) hg[dt] = p.head_gain[32 * dt + l31] * 0.8f;
#pragma unroll
        for (int r = 0; r < 16; ++r) {
            float o[4], ss = 0.f;
#pragma unroll
            for (int dt = 0; dt < 4; ++dt) { o[dt] = O[dt][r] - ex[(dt * 16 + r) * 64 + lane]; ss += o[dt] * o[dt]; }
            ss += __shfl_xor(ss, 1); ss += __shfl_xor(ss, 2); ss += __shfl_xor(ss, 4); ss += __shfl_xor(ss, 8); ss += __shfl_xor(ss, 16);
            const float rs = __builtin_amdgcn_rsqf(ss * (1.0f / 128.0f) + EPS);
            char* op = (char*)(p.AO + (tok0 + q0 + wq * 32 + (r & 3) + 8 * (r >> 2)) * 1024 + h * 128);
#pragma unroll
            for (int dt = 0; dt < 4; ++dt) *(bf16_t*)(op + 64 * dt + aovoff) = f2bf(o[dt] * rs * hg[dt]);
        }
    }
    __syncthreads();
}

#define XB_TMO      128
#define XB_XCNT(j)  (256  + 64 * (j))
#define XB_XSUB(j)  (1280 + 64 * (j))
#define XB_XGEN(j)  (2304 + 64 * (j))
#define XB_TOP      3328
#define XB_TOPGEN   3392
#define XCD_BAR_WORDS 3456
#define XB_SPIN_CAP (1u << 18)

__device__ __forceinline__ unsigned xb_ld(unsigned* p)              { return __hip_atomic_load(p, __ATOMIC_RELAXED, __HIP_MEMORY_SCOPE_AGENT); }
__device__ __forceinline__ unsigned xb_add(unsigned* p, unsigned v) { return __hip_atomic_fetch_add(p, v, __ATOMIC_RELAXED, __HIP_MEMORY_SCOPE_AGENT); }
__device__ __forceinline__ unsigned xb_xcc_id() { return (unsigned)__builtin_amdgcn_s_getreg((3 << 11) | 20) & 0xFu; }
#define XB_SPIN(cond, bar) do { unsigned _sp = 0; while (cond) { __builtin_amdgcn_s_sleep(1); \
    if ((++_sp & 255u) == 0u) { if (xb_ld(&(bar)[XB_TMO])) break; if (_sp > XB_SPIN_CAP) { atomicAdd(&(bar)[XB_TMO], 1u); break; } } } } while (0)

struct XcdBarrier {
    unsigned* bar; unsigned x;
    volatile LAS unsigned* st;
};

__device__ __forceinline__ XcdBarrier xcd_barrier_post(unsigned* bar, volatile LAS unsigned* st) {
    XcdBarrier b; b.bar = bar; b.x = xb_xcc_id(); b.st = st;
    if (threadIdx.x == 0) (void)xb_add(&bar[XB_XCNT(b.x)], 1u);
    return b;
}
__device__ __forceinline__ void xcd_barrier_complete(unsigned* bar, unsigned x, unsigned& nloc, unsigned& nx) {
    const unsigned G = gridDim.x * gridDim.y * gridDim.z;
    unsigned sum, cnt, mine, sp = 0u;
    for (;;) {
        sum = 0u; cnt = 0u; mine = 0u;
#pragma unroll
        for (unsigned j = 0; j < 16; ++j) { const unsigned c = xb_ld(&bar[XB_XCNT(j)]); sum += c; cnt += (c > 0u) ? 1u : 0u; mine = (j == x) ? c : mine; }
        if (sum == G) break;
        __builtin_amdgcn_s_sleep(1);
        if ((++sp & 255u) == 0u) { if (xb_ld(&bar[XB_TMO])) break; if (sp > XB_SPIN_CAP) { atomicAdd(&bar[XB_TMO], 1u); break; } }
    }
    nloc = mine > 0u ? mine : 1u; nx = cnt > 0u ? cnt : 1u;
}

__device__ __forceinline__ void xcd_barrier(const XcdBarrier& b) {
    asm volatile("s_waitcnt vmcnt(0)" ::: "memory");
    __syncthreads();
    if (threadIdx.x == 0) {
        unsigned* bar = b.bar;
        __builtin_amdgcn_s_waitcnt(0);
        unsigned nloc = b.st[0], nx = b.st[1];
        if (nloc == 0u) { xcd_barrier_complete(bar, b.x, nloc, nx); b.st[0] = nloc; b.st[1] = nx; }
        const unsigned old = xb_add(&bar[XB_XSUB(b.x)], 1u);
        const unsigned gen = old / nloc;
        if (old + 1u == (gen + 1u) * nloc) {
            __builtin_amdgcn_fence(__ATOMIC_RELEASE, "agent");
            asm volatile("s_waitcnt vmcnt(0)" ::: "memory");
            const unsigned og = xb_add(&bar[XB_TOP], 1u);
            const unsigned tg = og / nx;
            if (og + 1u == (tg + 1u) * nx) xb_add(&bar[XB_TOPGEN], 1u);
            else XB_SPIN(xb_ld(&bar[XB_TOPGEN]) == tg, bar);
            __builtin_amdgcn_fence(__ATOMIC_ACQUIRE, "agent");
            xb_add(&bar[XB_XGEN(b.x)], 1u);
            asm volatile("s_waitcnt vmcnt(0)" ::: "memory");
        } else {
            XB_SPIN(xb_ld(&bar[XB_XGEN(b.x)]) == gen, bar);
            __builtin_amdgcn_fence(__ATOMIC_ACQUIRE, "agent");
            asm volatile("s_waitcnt vmcnt(0)" ::: "memory");
        }
    }
    __syncthreads();
}


__device__ __forceinline__ void grid_bar(unsigned* cnt, unsigned target) {
    asm volatile("s_waitcnt vmcnt(0)" ::: "memory");
    __syncthreads();
    if (threadIdx.x == 0) {
        __builtin_amdgcn_fence(__ATOMIC_RELEASE, "agent");
        asm volatile("s_waitcnt vmcnt(0)" ::: "memory");
        __hip_atomic_fetch_add(cnt, 1u, __ATOMIC_RELAXED, __HIP_MEMORY_SCOPE_AGENT);
        while (__hip_atomic_load(cnt, __ATOMIC_RELAXED, __HIP_MEMORY_SCOPE_AGENT) < target) __builtin_amdgcn_s_sleep(2);
        __builtin_amdgcn_fence(__ATOMIC_ACQUIRE, "agent");
        asm volatile("s_waitcnt vmcnt(0)" ::: "memory");
    }
    __syncthreads();
}
__global__ void __launch_bounds__(512, 2) mega(Args a) {
    extern __shared__ __attribute__((aligned(16))) unsigned char lds_raw[];
    LAS unsigned char* lds = (LAS unsigned char*)lds_raw;
    const int tid = threadIdx.x, lane = tid & 63, wave = __builtin_amdgcn_readfirstlane(tid >> 6);
    const int G = gridDim.x, bx = blockIdx.x;
    const int vcu = (G % 8 == 0) ? (bx % 8) * (G / 8) + bx / 8 : bx;
    const int gw = vcu * 8 + wave, NGW = G * 8;
    unsigned char* ws = a.ws;
    bf16_t* WinT = (bf16_t*)(ws + WS_WIN); bf16_t* WbaT = (bf16_t*)(ws + WS_WBA); bf16_t* WblT = (bf16_t*)(ws + WS_WBL); bf16_t* WoT = (bf16_t*)(ws + WS_WO);
    bf16_t* WupT = (bf16_t*)(ws + WS_WUP); bf16_t* WdnT = (bf16_t*)(ws + WS_WDN); bf16_t* WRt = (bf16_t*)(ws + WS_WR); bf16_t* WIt = (bf16_t*)(ws + WS_WI);
    float* AGG = (float*)(ws + WS_AGG); float* RSS = (float*)(ws + WS_RSS);
    bf16_t* S0 = (bf16_t*)(ws + WS_SLOT0); bf16_t* S1 = (bf16_t*)(ws + WS_SLOT0 + SLOT); bf16_t* S2 = (bf16_t*)(ws + WS_SLOT0 + 2 * SLOT); bf16_t* S3 = (bf16_t*)(ws + WS_SLOT0 + 3 * SLOT);
    bf16_t* S4 = (bf16_t*)(ws + WS_SLOT0 + 4 * SLOT); bf16_t* S5 = (bf16_t*)(ws + WS_SLOT0 + 5 * SLOT);
    bf16_t *XN = S0, *BO = S0, *Qb = S1, *AO = S1, *Kb = S2, *MG = S2, *VT = S3, *TMP = S4, *XL = S4, *GG = S5, *HB = S5, *UP = S0;
    bf16_t* GA = (bf16_t*)(a.out + O_Y); bf16_t* GB = GA + (size_t)T * 1024;
    float* H = a.out + O_Y;
    const int lo = a.ph_lo, hi_ph = a.ph_hi;
#ifdef ONLYPH
#define IN(k) ((k) == ONLYPH && lo <= (k) && (k) < hi_ph)
#else
#define IN(k) (lo <= (k) && (k) < hi_ph)
#endif
    unsigned* barcnt = (unsigned*)(ws + WS_CTL);
    volatile LAS unsigned* xst = (volatile LAS unsigned*)(lds + LDS_BYTES - 16);
    if (tid < 2) xst[tid] = 0u;
    __syncthreads();
    const XcdBarrier xbar = xcd_barrier_post((unsigned*)(ws + WS_XB), xst);
    if (a.ph_lo < 0) cg::this_grid().sync();
#define SYNC(k) do { if (IN(k) && IN((k) + 1)) xcd_barrier(xbar); } while (0)

    if (IN(0)) for (int rep = 0; rep < REPN(0); ++rep) {
        LAS float* scr = (LAS float*)(lds + wave * 16384);
        constexpr int I_IN = 16 * 224, I_SQ = 16 * 32, I_UP = 16 * 128, I_DN = 64 * 32, I_G = 32;
        constexpr int NIT = I_IN + 3 * I_SQ + I_UP + I_DN + 2 * I_G;
        for (int it = gw; it < NIT; it += NGW) {
            int r = it;
            if (r < I_IN) { transpose_item(a.w_in, 1024, NIN, nullptr, WinT, scr, r, lane); continue; } r -= I_IN;
            if (r < I_SQ) { transpose_item(a.w_ba, 1024, 1024, nullptr, WbaT, scr, r, lane); continue; } r -= I_SQ;
            if (r < I_SQ) { transpose_item(a.w_bl, 1024, 1024, nullptr, WblT, scr, r, lane); continue; } r -= I_SQ;
            if (r < I_SQ) { transpose_item(a.w_o, 1024, 1024, nullptr, WoT, scr, r, lane); continue; } r -= I_SQ;
            if (r < I_UP) { transpose_item(a.w_up, 1024, FF, a.norm_mlp, WupT, scr, r, lane); continue; } r -= I_UP;
            if (r < I_DN) { transpose_item(a.w_down, FF, 1024, nullptr, WdnT, scr, r, lane); continue; } r -= I_DN;
            if (r < I_G) { transpose_item(a.w_rgate + (size_t)(r >> 1) * 4096, 64, 64, nullptr, WRt + (size_t)(r >> 1) * 4096, scr, r & 1, lane); continue; } r -= I_G;
            transpose_item(a.w_igate + (size_t)(r >> 1) * 4096, 64, 64, nullptr, WIt + (size_t)(r >> 1) * 4096, scr, r & 1, lane);
        }
        f32x4 g[4];
#pragma unroll
        for (int j = 0; j < 4; ++j) g[j] = ((const f32x4*)a.norm_mix)[lane + 64 * j];
        for (int m = gw; m < T; m += NGW) {
            const float* xr = (m < TP) ? a.x_prompt + (size_t)m * 1024 : a.x_sample + (size_t)(m - TP) * 1024;
            f32x4 v[4]; float s = 0.f;
#pragma unroll
            for (int j = 0; j < 4; ++j) { v[j] = ((const f32x4*)xr)[lane + 64 * j]; s += (v[j][0] * v[j][0] + v[j][1] * v[j][1]) + (v[j][2] * v[j][2] + v[j][3] * v[j][3]); }
            const float rstd = 1.0f / sqrtf(wave_sum(s) * (1.0f / 1024.0f) + EPS);
            u32x2* o = (u32x2*)(XN + (size_t)m * 1024);
#pragma unroll
            for (int j = 0; j < 4; ++j) { u32x2 w2; w2.x = pk2(v[j][0] * rstd * g[j][0], v[j][1] * rstd * g[j][1]); w2.y = pk2(v[j][2] * rstd * g[j][2], v[j][3] * rstd * g[j][3]); o[lane + 64 * j] = w2; }
        }
    }
    SYNC(0);
    if (IN(1)) for (int rep = 0; rep < REPN(1); ++rep) {
        pg8::Gemm g{XN, WinT, T, NIN, 1024, 1024}; pg8::StaticOrder S; S.init(T, NIN, G, bx);
        EpiIn E{Qb, Kb, VT, XL, GG, GA, GB, a.out};
        pg8::gemm_phase<EpiIn, pg8::StaticOrder, true, true>(lds, g, S, E);
    }
    SYNC(1);
    float* CARRY = (float*)(ws + WS_CARRY);
    LruP lp{XL, GG, WRt, WIt, BO, S2, S3, AGG, CARRY, a.conv_w, a.conv_b, a.b_rgate, a.b_igate, a.lru_lambda, a.state_conv, a.state_lru, a.out};
    if (IN(2)) {
        float lam;
        { const float q0 = a.lambda_q[lane], k0 = a.lambda_k[lane], q1 = a.lambda_q[64 + lane], k1 = a.lambda_k[64 + lane];
          lam = __expf(wave_sum(q0 * k0)) - __expf(wave_sum(q1 * k1)) + 0.2f; }
        AttP ap{Qb, Kb, VT, AO, a.cache_k, a.cache_v, a.head_gain, a.flags};
        { const int nsamp = (vcu < 256) ? (255 - vcu) / G + 1 : 0, npr = (vcu < 1024) ? 2 * ((1023 - vcu) / G + 1) : 0;
          const int ss = nsamp ? (vcu % (npr + 1)) : -1;
          int si = 0, pi = 0;
          for (int k = 0; k < npr + nsamp; ++k) {
              const bool is_s = (si < nsamp) && (k == ss || pi >= npr);
              if (is_s) { const int u = vcu + si * G; attn_unit<true>(ap, (LAS char*)lds, u >> 3, u & 7, 0, lam); ++si; }
              else { const int pr = vcu + (pi >> 1) * G, bh = pr >> 5, s = pr & 31; attn_unit<false>(ap, (LAS char*)lds, bh >> 3, bh & 7, (pi & 1) ? s : 63 - s, lam); ++pi; } } }
    }
    SYNC(2);
    if (IN(3)) {
        LAS char* scr = (LAS char*)lds + wave * 9216;
        for (int it = gw; it < 544 * 16; it += NGW) lru_item<false>(lp, scr, it >> 4, it & 15, lane);
    }
    SYNC(3);
    if (IN(4)) {
        if (vcu < 8) {
            const int gt = vcu * 512 + tid; const int b = gt >> 10, ch = gt & 1023; const float* ag = AGG + (size_t)(b * 128) * 2048 + ch; float* cr = CARRY + (size_t)(b * 128) * 1024 + ch; float h = 0.f;
#pragma unroll 16
            for (int j = 0; j < 128; ++j) { cr[(size_t)j * 1024] = h; h = ag[(size_t)j * 2048] * h + ag[(size_t)j * 2048 + 1024]; }
            asm volatile("s_waitcnt vmcnt(0)" ::: "memory"); __syncthreads();
            if (tid == 0) { __builtin_amdgcn_fence(__ATOMIC_RELEASE, "agent"); asm volatile("s_waitcnt vmcnt(0)" ::: "memory"); __hip_atomic_fetch_add(barcnt + 32, 1u, __ATOMIC_RELAXED, __HIP_MEMORY_SCOPE_AGENT); }
        }
        { pg8::Gemm g{AO, WbaT, T, 1024, 1024, 1024}; pg8::StaticOrder S; S.init(T, 1024, G, bx); EpiM1 E{GA, TMP};
          pg8::gemm_phase<EpiM1, pg8::StaticOrder, true, true>(lds, g, S, E); }
        while (__builtin_amdgcn_readfirstlane((int)__hip_atomic_load(barcnt + 32, __ATOMIC_RELAXED, __HIP_MEMORY_SCOPE_AGENT)) < (G < 8 ? G : 8)) __builtin_amdgcn_s_sleep(2);
        __builtin_amdgcn_fence(__ATOMIC_ACQUIRE, "agent"); asm volatile("s_waitcnt vmcnt(0)" ::: "memory");
        for (int it = vcu + G * wave; it < 544 * 2; it += NGW) lru_final_light(lp, it >> 1, it & 1, lane);
    }
    SYNC(4);
    if (IN(5)) for (int rep = 0; rep < REPN(5); ++rep) {
        { pg8::Gemm g{BO, WblT, T, 1024, 1024, 1024}; pg8::StaticOrder S; S.init(T, 1024, G, bx); EpiM2 E{GB, TMP, MG};
          pg8::gemm_phase<EpiM2, pg8::StaticOrder, true, true>(lds, g, S, E); }
    }
    SYNC(5);
    if (IN(6)) for (int rep = 0; rep < REPN(6); ++rep) {
        pg8::Gemm g{MG, WoT, T, 1024, 1024, 1024}; pg8::StaticOrder S; S.init(T, 1024, G, bx); EpiO E{a.x_prompt, a.x_sample, H, HB, RSS};
        pg8::gemm_phase<EpiO, pg8::StaticOrder, true, true>(lds, g, S, E);
    }
    SYNC(6);
    if (IN(7)) for (int rep = 0; rep < REPN(7); ++rep) {
        pg8::Gemm g{HB, WupT, T, FF, 1024, 1024}; pg8::StaticOrder S; S.init(T, FF, G, bx); EpiUp E{RSS, UP};
        pg8::gemm_phase<EpiUp, pg8::StaticOrder, true, true>(lds, g, S, E);
    }
    SYNC(7);
    if (IN(8)) {
        { pg8::Gemm g{UP, WdnT, TP, 1024, FF, FF}; pg8::StaticOrder S; S.init(TP, 1024, G, bx); EpiDown E{H};
          pg8::gemm_phase<EpiDown, pg8::StaticOrder, true, true>(lds, g, S, E); }
        { pg8::Gemm g{UP, WdnT, T, 1024, 512, FF}; SplitOrder S{G, bx}; EpiPart E{(float*)S4};
          pg8::gemm_phase<EpiPart, SplitOrder, true, true>(lds, g, S, E); }
    }
    SYNC(8);
    if (IN(9)) {
        f32x4 g[4];
#pragma unroll
        for (int j = 0; j < 4; ++j) g[j] = ((const f32x4*)a.norm_final)[lane + 64 * j];
        for (int m = gw; m < T; m += NGW) {
            f32x4* xr = (f32x4*)(H + (size_t)m * 1024);
            f32x4 v[4]; float s = 0.f;
#pragma unroll
            for (int j = 0; j < 4; ++j) v[j] = xr[lane + 64 * j];
            if (m >= TP) {
                const f32x4* pp = (const f32x4*)((const float*)S4 + (size_t)(m - TP) * 1024) + lane;
#pragma unroll
                for (int kc = 0; kc < 8; ++kc)
#pragma unroll
                    for (int j = 0; j < 4; ++j) v[j] += pp[(size_t)kc * 2048 * 256 + 64 * j];
            }
#pragma unroll
            for (int j = 0; j < 4; ++j) s += (v[j][0] * v[j][0] + v[j][1] * v[j][1]) + (v[j][2] * v[j][2] + v[j][3] * v[j][3]);
            const float rstd = 1.0f / sqrtf(wave_sum(s) * (1.0f / 1024.0f) + EPS);
#pragma unroll
            for (int j = 0; j < 4; ++j) xr[lane + 64 * j] = v[j] * rstd * g[j];
        }
    }
#undef IN
#undef SYNC
}

constexpr int NPH = 10;
#ifndef MK_LAUNCHES
#define MK_LAUNCHES 1
#endif
extern "C" void kernel_launch(void* const* d_in, const int* in_sizes, int n_in, void* d_out, int out_size, void* d_ws, size_t ws_size, hipStream_t stream) {
    static int grid = 0;
    if (grid == 0) {
        if (n_in != 25 || ws_size < WS_END) { fprintf(stderr, "kernel_launch: unexpected n_in %d / ws %zu (need %zu)\n", n_in, ws_size, (size_t)WS_END); grid = -1; return; }
        int dev = 0, cus = 0, per_cu = 0;
        hipGetDevice(&dev); hipDeviceGetAttribute(&cus, hipDeviceAttributeMultiprocessorCount, dev);
        if (hipFuncSetAttribute((const void*)mega, hipFuncAttributeMaxDynamicSharedMemorySize, LDS_BYTES) != hipSuccess) { fprintf(stderr, "hipFuncSetAttribute failed\n"); grid = -1; return; }
        hipOccupancyMaxActiveBlocksPerMultiprocessor(&per_cu, (const void*)mega, 512, LDS_BYTES);
        if (per_cu < 1) { fprintf(stderr, "occupancy query says %d\n", per_cu); per_cu = 1; }
        (void)hipGetLastError();
        grid = cus * 1;
    }
    if (grid < 0) return;
    if (hipMemsetAsync((char*)d_ws + WS_CTL, 0, 256, stream) != hipSuccess) { fprintf(stderr, "memset failed\n"); return; }
    if (hipMemsetAsync((char*)d_ws + WS_XB, 0, 16384, stream) != hipSuccess) { fprintf(stderr, "memset failed\n"); return; }
    Args a{};
    const float** pf = (const float**)&a;
    for (int i = 0; i < 25; ++i) pf[i] = (const float*)d_in[i];
    a.out = (float*)d_out; a.ws = (unsigned char*)d_ws;
#if MK_LAUNCHES == 1
#ifdef PROBE_PREFIX
    { a.ph_lo = 0; a.ph_hi = PROBE_PREFIX; a.flags = PROBE_FLAGS; void* args0[] = {&a};
      if (hipLaunchCooperativeKernel((const void*)mega, dim3(grid), dim3(512), args0, LDS_BYTES, stream) != hipSuccess) fprintf(stderr, "probe launch failed\n");
      if (hipMemsetAsync((char*)d_ws + WS_CTL, 0, 256, stream) != hipSuccess) fprintf(stderr, "memset failed\n"); }
#endif
    a.ph_lo = 0; a.ph_hi = NPH; a.flags = 0;
    void* args[] = {&a};
    hipError_t e = hipLaunchCooperativeKernel((const void*)mega, dim3(grid), dim3(512), args, LDS_BYTES, stream);
    if (e != hipSuccess) fprintf(stderr, "cooperative launch failed: %s (grid %d)\n", hipGetErrorString(e), grid);
#else
    for (int k = 0; k < NPH; ++k) { a.ph_lo = k; a.ph_hi = k + 1; hipLaunchKernelGGL(mega, dim3(grid), dim3(512), LDS_BYTES, stream, a); }
#endif
}
```

```cpp
#include <hip/hip_runtime.h>
#include <hip/hip_cooperative_groups.h>
#include <cstdio>
#include <cstdint>
namespace cg = cooperative_groups;
namespace pg8 {
#define PG8_LAS __attribute__((address_space(3)))
typedef unsigned short bf16_t;
typedef short bf16x8 __attribute__((ext_vector_type(8)));
typedef float f32x4 __attribute__((ext_vector_type(4)));
typedef unsigned u32x4 __attribute__((ext_vector_type(4)));
constexpr int BM = 256, BK = 64, HALF = 128, HTB = HALF * BK * 2  , STAGE_BYTES = 8 * HTB, NXCD = 8, WGM = 8;

__host__ __device__ __forceinline__ int lds_byte(int r, int c) { const int st = (r >> 4) * 2 + (c >> 5), rr = r & 15, cc = c & 31, ob = rr * 64 + cc * 2; return st * 1024 + (ob ^ (((ob >> 9) & 1) << 5)); }
__host__ __device__ __forceinline__ void stage_rc(int b, int& R, int& C) { const int st = b / 1024, sb = b % 1024, swz = sb ^ (((sb >> 9) & 1) << 5); R = (st >> 1) * 16 + swz / 64; C = (st & 1) * 32 + (swz % 64) / 2; }
__host__ __device__ __forceinline__ int perm32(int rho) { const int n = rho >> 4, i = rho & 15; return 8 * (i >> 2) + 4 * n + (i & 3); }

struct Unit { int pm, pn, kc; };
struct Gemm { const bf16_t* A; const bf16_t* Bt; int M, N, K, ld; };

struct StaticOrder {
    int nM, nN, nwg, G, c;
    __host__ __device__ void init(int M, int N, int G_, int c_) { nM = M / BM; nN = N / BM; nwg = nM * nN; G = G_; c = c_; }
    __host__ __device__ bool next(int i, Unit& u) const {
        const long L = (long)i * G + c; if (L >= nwg) return false;
        int wgid = (int)L; { const int q = nwg / NXCD, r = nwg % NXCD, xcd = wgid % NXCD, off = wgid / NXCD; wgid = (xcd < r ? xcd * (q + 1) : r * (q + 1) + (xcd - r) * q) + off; }
        const int nig = WGM * nN, gid = wgid / nig, fm = gid * WGM, gsz = (nM - fm) < WGM ? (nM - fm) : WGM;
        u.pm = fm + ((wgid % nig) % gsz); u.pn = (wgid % nig) / gsz; u.kc = 0; return true;
    }
    __device__ __forceinline__ void a_ready(const Unit&) const {}
    __device__ __forceinline__ void done(const Unit&) const {}
};

template <class Epi, class Sched, bool ALIGN_EPI = false, bool SP2 = false>
__device__ __forceinline__ void gemm_phase(PG8_LAS unsigned char* lds, const Gemm g, const Sched& S, const Epi& E) {
    const int tid = threadIdx.x, wid = __builtin_amdgcn_readfirstlane(tid >> 6), lane = tid & 63, wr = wid >> 2, wc = wid & 3, fr = lane & 15, fq = lane >> 4;
    const int K = g.ld, nt = g.K / BK; const size_t kcb = (size_t)g.K * 2;
    unsigned voffA[2], voffB[2];
#pragma unroll
    for (int i = 0; i < 2; ++i) { int R, C; stage_rc(tid * 16 + i * 8192, R, C); const int Rb = Epi::PERM ? ((R & ~31) + perm32(R & 31)) : R;
        voffA[i] = (unsigned)(R * K + C) * 2u; voffB[i] = (unsigned)(Rb * K + C) * 2u; }
    const size_t kstep = (size_t)(BK * 2);
    const size_t hstep = (size_t)HALF * K * 2;
    const size_t tstep = 2 * hstep;
    const unsigned ldsw = (unsigned)wid * 1024u;
    const int aoff = lds_byte(wr * 64 + fr, fq * 8), boff = lds_byte(wc * 32 + fr, fq * 8);
#define PG8_SA(b, h) (((b) * 2 + (h)) * HTB)
#define PG8_SB(b, h) ((4 + (b) * 2 + (h)) * HTB)
#define PG8_STAGE(bufoff, gbase, voff) do { _Pragma("unroll") for (int _i = 0; _i < 2; ++_i) \
        __builtin_amdgcn_global_load_lds((const unsigned*)((const char*)(gbase) + (voff)[_i]), (PG8_LAS unsigned*)(lds + (bufoff) + ldsw + _i * 8192), 16, 0, 0); } while (0)
#define PG8_LDA(dst, b, h) do { _Pragma("unroll") for (int m = 0; m < 4; ++m) _Pragma("unroll") for (int k = 0; k < 2; ++k) dst[m][k] = *(const PG8_LAS bf16x8*)(lds + PG8_SA(b, h) + aoff + m * 2048 + k * 1024); } while (0)
#define PG8_LDB(dst, b, h) do { _Pragma("unroll") for (int n = 0; n < 2; ++n) _Pragma("unroll") for (int k = 0; k < 2; ++k) dst[n][k] = *(const PG8_LAS bf16x8*)(lds + PG8_SB(b, h) + boff + n * 2048 + k * 1024); } while (0)
#define PG8_MMA(ai, bj, At, Bt) do { __builtin_amdgcn_s_setprio(1); _Pragma("unroll") for (int m = 0; m < 4; ++m) _Pragma("unroll") for (int n = 0; n < 2; ++n) _Pragma("unroll") for (int k = 0; k < 2; ++k) \
        acc[ai][bj][m][n] = __builtin_amdgcn_mfma_f32_16x16x32_bf16(Bt[n][k], At[m][k], acc[ai][bj][m][n], 0, 0, 0); __builtin_amdgcn_s_setprio(0); } while (0)
#define PG8_WAIT_V(n) asm volatile("s_waitcnt vmcnt(" #n ")" ::: "memory")
#define PG8_WAIT_L(n) asm volatile("s_waitcnt lgkmcnt(" #n ")" ::: "memory")
#define PG8_BAR __builtin_amdgcn_s_barrier()
#define PG8_SCHED __builtin_amdgcn_sched_barrier(0)
    Unit cur, nxt; int ui = 0;
    if (!S.next(0, cur)) return;
    f32x4 acc[2][2][4][2];
#pragma unroll
    for (int a = 0; a < 2; ++a)
#pragma unroll
        for (int b = 0; b < 2; ++b)
#pragma unroll
            for (int m = 0; m < 4; ++m)
#pragma unroll
                for (int n = 0; n < 2; ++n) acc[a][b][m][n] = (f32x4){0.f, 0.f, 0.f, 0.f};
    bf16x8 At[4][2], B0[2][2], B1[2][2];
    const char* cA = (const char*)g.A + (size_t)cur.pm * tstep + (size_t)cur.kc * kcb; const char* cB = (const char*)g.Bt + (size_t)cur.pn * tstep + (size_t)cur.kc * kcb;
    S.a_ready(cur);
    if constexpr (SP2) {
        PG8_STAGE(PG8_SB(0, 0), cB, voffB); PG8_STAGE(PG8_SB(0, 1), cB + hstep, voffB); PG8_STAGE(PG8_SA(0, 0), cA, voffA); PG8_STAGE(PG8_SA(0, 1), cA + hstep, voffA);
        if (wr == 1) PG8_BAR;
        PG8_WAIT_V(2); PG8_BAR;
        PG8_STAGE(PG8_SB(1, 0), cB + kstep, voffB); PG8_STAGE(PG8_SA(1, 0), cA + kstep, voffA); PG8_STAGE(PG8_SB(1, 1), cB + hstep + kstep, voffB);
        PG8_WAIT_V(6); PG8_BAR;
    } else {
        PG8_STAGE(PG8_SB(0, 0), cB, voffB); PG8_STAGE(PG8_SA(0, 0), cA, voffA); PG8_STAGE(PG8_SB(0, 1), cB + hstep, voffB); PG8_STAGE(PG8_SA(0, 1), cA + hstep, voffA);
        if (wr == 1) PG8_BAR;
        PG8_WAIT_V(4); PG8_BAR;
        PG8_STAGE(PG8_SB(1, 0), cB + kstep, voffB); PG8_STAGE(PG8_SA(1, 0), cA + kstep, voffA); PG8_STAGE(PG8_SB(1, 1), cB + hstep + kstep, voffB);
        PG8_WAIT_V(6); PG8_BAR;
    }
    for (;;) {
        const bool has_next = S.next(ui + 1, nxt);
        const char* nA = has_next ? (const char*)g.A + (size_t)nxt.pm * tstep + (size_t)nxt.kc * kcb : cA; const char* nB = has_next ? (const char*)g.Bt + (size_t)nxt.pn * tstep + (size_t)nxt.kc * kcb : cB;
        for (int t = 0; t < nt; t += 2) {
            const bool last = (t == nt - 2);
            const char* a1 = cA + (size_t)(t + 1) * kstep;
            const char* a2 = last ? nA : cA + (size_t)(t + 2) * kstep; const char* b2 = last ? nB : cB + (size_t)(t + 2) * kstep;
            const char* a3 = a2 + kstep; const char* b3 = b2 + kstep;
            if (last && has_next) S.a_ready(nxt);
            if constexpr (SP2) {
            PG8_LDB(B0, 0, 0); PG8_LDB(B1, 0, 1); PG8_SCHED; PG8_LDA(At, 0, 0); PG8_STAGE(PG8_SA(1, 1), a1 + hstep, voffA);
            PG8_WAIT_V(8); PG8_WAIT_L(0); PG8_BAR; PG8_MMA(0, 0, At, B0); PG8_MMA(0, 1, At, B1); PG8_BAR; PG8_SCHED;
            PG8_LDA(At, 0, 1); PG8_STAGE(PG8_SB(0, 0), b2, voffB); PG8_STAGE(PG8_SB(0, 1), b2 + hstep, voffB); PG8_STAGE(PG8_SA(0, 0), a2, voffA);
            PG8_WAIT_V(8); PG8_WAIT_L(0); PG8_BAR; PG8_MMA(1, 0, At, B0); PG8_MMA(1, 1, At, B1); PG8_BAR; PG8_SCHED;
            PG8_LDB(B0, 1, 0); PG8_LDB(B1, 1, 1); PG8_SCHED; PG8_LDA(At, 1, 0); PG8_STAGE(PG8_SA(0, 1), a2 + hstep, voffA);
            PG8_WAIT_V(8); PG8_WAIT_L(0); PG8_BAR; PG8_MMA(0, 0, At, B0); PG8_MMA(0, 1, At, B1); PG8_BAR; PG8_SCHED;
            PG8_LDA(At, 1, 1); PG8_STAGE(PG8_SB(1, 0), b3, voffB); PG8_STAGE(PG8_SB(1, 1), b3 + hstep, voffB); PG8_STAGE(PG8_SA(1, 0), a3, voffA);
            PG8_WAIT_V(8); PG8_WAIT_L(0); PG8_BAR; PG8_MMA(1, 0, At, B0); PG8_MMA(1, 1, At, B1); PG8_BAR; PG8_SCHED;
            } else {
            PG8_LDB(B0, 0, 0); PG8_SCHED; PG8_LDA(At, 0, 0); PG8_STAGE(PG8_SA(1, 1), a1 + hstep, voffA);
            PG8_WAIT_L(8); PG8_BAR; PG8_WAIT_L(0); PG8_MMA(0, 0, At, B0); PG8_BAR; PG8_SCHED;
            PG8_LDB(B1, 0, 1); PG8_STAGE(PG8_SB(0, 0), b2, voffB);
            PG8_BAR; PG8_WAIT_L(0); PG8_MMA(0, 1, At, B1); PG8_BAR;
            PG8_LDA(At, 0, 1); PG8_STAGE(PG8_SA(0, 0), a2, voffA);
            PG8_BAR; PG8_WAIT_L(0); PG8_MMA(1, 0, At, B0); PG8_BAR; PG8_SCHED;
            PG8_STAGE(PG8_SB(0, 1), b2 + hstep, voffB);
            PG8_WAIT_V(6); PG8_BAR; PG8_MMA(1, 1, At, B1); PG8_BAR;
            PG8_LDB(B0, 1, 0); PG8_SCHED; PG8_LDA(At, 1, 0); PG8_STAGE(PG8_SA(0, 1), a2 + hstep, voffA);
            PG8_WAIT_L(8); PG8_BAR; PG8_WAIT_L(0); PG8_MMA(0, 0, At, B0); PG8_BAR; PG8_SCHED;
            PG8_LDB(B1, 1, 1); PG8_STAGE(PG8_SB(1, 0), b3, voffB);
            PG8_BAR; PG8_WAIT_L(0); PG8_MMA(0, 1, At, B1); PG8_BAR;
            PG8_LDA(At, 1, 1); PG8_STAGE(PG8_SA(1, 0), a3, voffA);
            PG8_BAR; PG8_WAIT_L(0); PG8_MMA(1, 0, At, B0); PG8_BAR; PG8_SCHED;
            PG8_STAGE(PG8_SB(1, 1), b3 + hstep, voffB);
            PG8_WAIT_V(6); PG8_BAR; PG8_MMA(1, 1, At, B1); PG8_BAR;
            }
        }
        if constexpr (ALIGN_EPI) { if (wr == 0) PG8_BAR; }
        if constexpr (!Epi::AFTER_DRAIN) { E(acc, cur, wr, wc, fr, fq); S.done(cur); }
        if (!has_next) break;
#pragma unroll
        for (int a = 0; a < 2; ++a)
#pragma unroll
            for (int b = 0; b < 2; ++b)
#pragma unroll
                for (int m = 0; m < 4; ++m)
#pragma unroll
                    for (int n = 0; n < 2; ++n) acc[a][b][m][n] = (f32x4){0.f, 0.f, 0.f, 0.f};
        cur = nxt; cA = nA; cB = nB; ++ui;
        if constexpr (ALIGN_EPI) { if (wr == 1) PG8_BAR; }
    }
    PG8_WAIT_V(0);
    if constexpr (!ALIGN_EPI) { if (wr == 0) PG8_BAR; }
    PG8_BAR;
    if constexpr (Epi::AFTER_DRAIN) { E.fused(acc, cur, wr, wc, fr, fq, lds, wid, lane); S.done(cur); }
#undef PG8_SA
#undef PG8_SB
#undef PG8_STAGE
#undef PG8_LDA
#undef PG8_LDB
#undef PG8_MMA
#undef PG8_WAIT_V
#undef PG8_WAIT_L
#undef PG8_BAR
#undef PG8_SCHED
}
}

#define LAS __attribute__((address_space(3)))
typedef unsigned short bf16_t;
typedef short bf16x8 __attribute__((ext_vector_type(8)));
typedef short s16x4 __attribute__((ext_vector_type(4)));
typedef float f32x4 __attribute__((ext_vector_type(4)));
typedef float f32x16 __attribute__((ext_vector_type(16)));
typedef unsigned u32x4 __attribute__((ext_vector_type(4)));
typedef unsigned u32x2 __attribute__((ext_vector_type(2)));
typedef float f32x2_t __attribute__((ext_vector_type(2)));
typedef __bf16 bf16x2_t __attribute__((ext_vector_type(2)));

constexpr int T = 34816, TP = 32768, DM = 1024, NIN = 7168, FF = 4096, SEQP = 8192;
constexpr float EPS = 1e-6f;
constexpr float QSCALE = 0.125f * 1.4426950408889634f;
constexpr size_t O_Y = 0, O_KP = 35651584, O_VP = 69206016, O_CP = 102760448, O_LP = 102772736, O_KS = 102776832, O_VS = 104873984, O_CS = 106971136, O_LS = 107069440;
constexpr size_t SLOT = (size_t)T * 1024 * 2;
constexpr size_t WS_WIN = 0, WS_WBA = 14680064, WS_WBL = WS_WBA + 2097152, WS_WO = WS_WBL + 2097152, WS_WUP = WS_WO + 2097152, WS_WDN = WS_WUP + 8388608,
                 WS_WR = WS_WDN + 8388608, WS_WI = WS_WR + 131072, WS_AGG = WS_WI + 131072, WS_RSS = WS_AGG + 4194304, WS_CTL = WS_RSS + (size_t)34816 * 64, WS_CARRY = WS_CTL + 256, WS_XB = WS_CARRY + 2097152, WS_SLOT0 = 50331648;
static_assert(WS_XB + 16384 <= WS_SLOT0, "ws map");
constexpr size_t WS_END = WS_SLOT0 + 6 * SLOT;
constexpr int LDS_BYTES = 147456;
#ifndef PROBE_FLAGS
#define PROBE_FLAGS 0
#endif
#ifndef REPMASK
#define REPMASK 0
#endif
#define REPN(k) ((((REPMASK) >> (k)) & 1) ? 2 : 1)

struct Args {
    const float *x_prompt, *x_sample, *cache_k, *cache_v, *state_conv, *state_lru, *norm_mix, *norm_mlp, *norm_final, *w_in, *lambda_q, *lambda_k, *head_gain,
        *conv_w, *conv_b, *w_rgate, *b_rgate, *w_igate, *b_igate, *lru_lambda, *w_ba, *w_bl, *w_o, *w_up, *w_down;
    float* out; unsigned char* ws; int ph_lo, ph_hi, flags, pad;
};

__device__ __forceinline__ unsigned pk2(float lo, float hi) { f32x2_t v = {lo, hi}; bf16x2_t b = __builtin_convertvector(v, bf16x2_t); return __builtin_bit_cast(unsigned, b); }
__device__ __forceinline__ bf16_t f2bf(float f) { __bf16 b = (__bf16)f; return __builtin_bit_cast(unsigned short, b); }
__device__ __forceinline__ float bf2f(bf16_t u) { return __uint_as_float(((unsigned)u) << 16); }
__device__ __forceinline__ float bflo(unsigned u) { return __uint_as_float(u << 16); }
__device__ __forceinline__ float bfhi(unsigned u) { return __uint_as_float(u & 0xffff0000u); }
__device__ __forceinline__ float fsigmoid(float x) { return __builtin_amdgcn_rcpf(1.0f + __builtin_amdgcn_exp2f(-1.4426950408889634f * x)); }
__device__ __forceinline__ float gelu_tanh(float x) { const float y = 0.7978845608028654f * (x + 0.044715f * x * x * x); return x * fsigmoid(2.0f * y); }
__device__ __forceinline__ u32x4 pack8(const f32x4& a, const f32x4& b) { u32x4 w; w.x = pk2(a[0], a[1]); w.y = pk2(a[2], a[3]); w.z = pk2(b[0], b[1]); w.w = pk2(b[2], b[3]); return w; }
__device__ __forceinline__ int crow(int r, int hi) { return (r & 3) + 8 * (r >> 2) + 4 * hi; }
#define LDS_FENCE() asm volatile("s_waitcnt lgkmcnt(0)" ::: "memory")
#define MFMA32(a, b, c) __builtin_amdgcn_mfma_f32_32x32x16_bf16((a), (b), (c), 0, 0, 0)

using pg8::Unit;
#define EPI_LOOP(...) _Pragma("unroll") for (int ai = 0; ai < 2; ++ai) _Pragma("unroll") for (int m = 0; m < 4; ++m) { const int row = rbase + ai * 128 + m * 16; \
    _Pragma("unroll") for (int bj = 0; bj < 2; ++bj) { const int col = cbase + bj * 128; const f32x4 v0 = acc[ai][bj][m][0], v1 = acc[ai][bj][m][1]; __VA_ARGS__ } }

struct EpiIn {
    static constexpr bool PERM = true, AFTER_DRAIN = false;
    bf16_t *Q, *Kb, *VT, *XL, *GG, *GA, *GB; float* out;
    __device__ __forceinline__ void operator()(const f32x4 (&acc)[2][2][4][2], const Unit& u, int wr, int wc, int fr, int fq) const {
        const int sec = u.pn >> 2;
        const int cbase = (u.pn & 3) * 256 + wc * 32 + 8 * fq;
        const int rbase = u.pm * 256 + wr * 64 + fr;
        const bool prompt = u.pm < 128;
        if (sec == 0) {
            EPI_LOOP({ *(u32x4*)(Q + (size_t)row * 1024 + col) = pack8(v0 * QSCALE, v1 * QSCALE); })
        } else if (sec == 1) {
            float* ko = prompt ? out + O_KP : out + O_KS - (size_t)TP * 1024;
            EPI_LOOP({ float* o = ko + (size_t)row * 1024 + col; *(f32x4*)o = v0; *(f32x4*)(o + 4) = v1; *(u32x4*)(Kb + (size_t)row * 1024 + col) = pack8(v0, v1); })
        } else if (sec == 2) {
            float* vo = prompt ? out + O_VP : out + O_VS - (size_t)TP * 1024;
            EPI_LOOP({ float* o = vo + (size_t)row * 1024 + col; *(f32x4*)o = v0; *(f32x4*)(o + 4) = v1; *(u32x4*)(VT + (size_t)row * 1024 + col) = pack8(v0, v1); })
        } else if (sec == 3) {
            EPI_LOOP({ *(u32x4*)(XL + (size_t)row * 1024 + col) = pack8(v0, v1);
                if (prompt) { const int pos = row & (SEQP - 1); if (pos >= SEQP - 3) { float* o = out + O_CP + (size_t)((row >> 13) * 3 + pos - (SEQP - 3)) * 1024 + col; *(f32x4*)o = v0; *(f32x4*)(o + 4) = v1; } }
                else { const int rs = row - TP; const int pos = rs & 63; if (pos >= 61) { float* o = out + O_CS + (size_t)((rs >> 6) * 3 + pos - 61) * 1024 + col; *(f32x4*)o = v0; *(f32x4*)(o + 4) = v1; } } })
        } else if (sec == 4) {
            EPI_LOOP({ f32x4 a, b; _Pragma("unroll") for (int j = 0; j < 4; ++j) { a[j] = gelu_tanh(v0[j]); b[j] = gelu_tanh(v1[j]); }
                *(u32x4*)(GG + (size_t)row * 1024 + col) = pack8(a, b); })
        } else {
            bf16_t* G = (sec == 5) ? GA : GB;
            EPI_LOOP({ f32x4 a, b; _Pragma("unroll") for (int j = 0; j < 4; ++j) { a[j] = fsigmoid(v0[j]); b[j] = fsigmoid(v1[j]); }
                *(u32x4*)(G + (size_t)row * 1024 + col) = pack8(a, b); })
        }
    }
};
__device__ __forceinline__ void unpack8(const u32x4 w, f32x4& a, f32x4& b) { a[0] = bflo(w.x); a[1] = bfhi(w.x); a[2] = bflo(w.y); a[3] = bfhi(w.y); b[0] = bflo(w.z); b[1] = bfhi(w.z); b[2] = bflo(w.w); b[3] = bfhi(w.w); }
struct EpiM1 {
    static constexpr bool PERM = true, AFTER_DRAIN = false;
    const bf16_t* G; bf16_t* O;
    __device__ __forceinline__ void operator()(const f32x4 (&acc)[2][2][4][2], const Unit& u, int wr, int wc, int fr, int fq) const {
        const int cbase = u.pn * 256 + wc * 32 + 8 * fq, rbase = u.pm * 256 + wr * 64 + fr;
        EPI_LOOP({ f32x4 g0, g1; unpack8(*(const u32x4*)(G + (size_t)row * 1024 + col), g0, g1); *(u32x4*)(O + (size_t)row * 1024 + col) = pack8(g0 * v0, g1 * v1); })
    }
};
struct EpiM2 {
    static constexpr bool PERM = true, AFTER_DRAIN = false;
    const bf16_t* G; const bf16_t* Tm; bf16_t* O;
    __device__ __forceinline__ void operator()(const f32x4 (&acc)[2][2][4][2], const Unit& u, int wr, int wc, int fr, int fq) const {
        const int cbase = u.pn * 256 + wc * 32 + 8 * fq, rbase = u.pm * 256 + wr * 64 + fr;
        EPI_LOOP({ f32x4 g0, g1, t0, t1; unpack8(*(const u32x4*)(G + (size_t)row * 1024 + col), g0, g1); unpack8(*(const u32x4*)(Tm + (size_t)row * 1024 + col), t0, t1);
            *(u32x4*)(O + (size_t)row * 1024 + col) = pack8(t0 + g0 * v0, t1 + g1 * v1); })
    }
};
struct EpiO {
    static constexpr bool PERM = true, AFTER_DRAIN = false;
    const float *xp, *xs; float* H; bf16_t* HB; float* RSS;
    __device__ __forceinline__ void operator()(const f32x4 (&acc)[2][2][4][2], const Unit& u, int wr, int wc, int fr, int fq) const {
        const int cbase = u.pn * 256 + wc * 32 + 8 * fq, rbase = u.pm * 256 + wr * 64 + fr;
        const float* xb = (u.pm < 128) ? xp : xs - (size_t)TP * 1024;
#pragma unroll
        for (int ai = 0; ai < 2; ++ai)
#pragma unroll
            for (int m = 0; m < 4; ++m) { const int row = rbase + ai * 128 + m * 16; float ss = 0.f;
#pragma unroll
                for (int bj = 0; bj < 2; ++bj) { const int col = cbase + bj * 128; const float* xr = xb + (size_t)row * 1024 + col;
                    const f32x4 h0 = *(const f32x4*)xr + acc[ai][bj][m][0], h1 = *(const f32x4*)(xr + 4) + acc[ai][bj][m][1];
                    float* o = H + (size_t)row * 1024 + col; *(f32x4*)o = h0; *(f32x4*)(o + 4) = h1;
                    *(u32x4*)(HB + (size_t)row * 1024 + col) = pack8(h0, h1);
                    ss += (h0[0] * h0[0] + h0[1] * h0[1]) + (h0[2] * h0[2] + h0[3] * h0[3]) + (h1[0] * h1[0] + h1[1] * h1[1]) + (h1[2] * h1[2] + h1[3] * h1[3]); }
                ss += __shfl_xor(ss, 16); ss += __shfl_xor(ss, 32);
                if (fq == 0) RSS[(size_t)row * 16 + u.pn * 4 + wc] = ss; }
    }
};
struct EpiUp {
    static constexpr bool PERM = true, AFTER_DRAIN = false;
    const float* RSS; bf16_t* UP;
    __device__ __forceinline__ void operator()(const f32x4 (&acc)[2][2][4][2], const Unit& u, int wr, int wc, int fr, int fq) const {
        const int cbase = u.pn * 256 + wc * 32 + 8 * fq, rbase = u.pm * 256 + wr * 64 + fr;
#pragma unroll
        for (int ai = 0; ai < 2; ++ai)
#pragma unroll
            for (int m = 0; m < 4; ++m) { const int row = rbase + ai * 128 + m * 16;
                const f32x4* rp = (const f32x4*)(RSS + (size_t)row * 16); const f32x4 s = (rp[0] + rp[1]) + (rp[2] + rp[3]);
                const float rstd = __builtin_amdgcn_rsqf(((s[0] + s[1]) + (s[2] + s[3])) * (1.0f / 1024.0f) + EPS);
#pragma unroll
                for (int bj = 0; bj < 2; ++bj) { const int col = cbase + bj * 128; f32x4 a = acc[ai][bj][m][0] * rstd, b = acc[ai][bj][m][1] * rstd;
#pragma unroll
                    for (int j = 0; j < 4; ++j) { a[j] = fmaxf(a[j], 0.f); a[j] *= a[j]; b[j] = fmaxf(b[j], 0.f); b[j] *= b[j]; }
                    *(u32x4*)(UP + (size_t)row * FF + col) = pack8(a, b); } }
    }
};
struct EpiDown {
    static constexpr bool PERM = true, AFTER_DRAIN = false;
    float* H;
    __device__ __forceinline__ void operator()(const f32x4 (&acc)[2][2][4][2], const Unit& u, int wr, int wc, int fr, int fq) const {
        const int cbase = u.pn * 256 + wc * 32 + 8 * fq, rbase = u.pm * 256 + wr * 64 + fr;
        EPI_LOOP({ float* o = H + (size_t)row * 1024 + col; const f32x4 h0 = *(const f32x4*)o + v0, h1 = *(const f32x4*)(o + 4) + v1; *(f32x4*)o = h0; *(f32x4*)(o + 4) = h1; })
    }
};

struct EpiPart {
    static constexpr bool PERM = true, AFTER_DRAIN = false;
    float* PART;
    __device__ __forceinline__ void operator()(const f32x4 (&acc)[2][2][4][2], const Unit& u, int wr, int wc, int fr, int fq) const {
        const int cbase = u.pn * 256 + wc * 32 + 8 * fq, rbase = u.pm * 256 + wr * 64 + fr;
        float* pb = PART + (size_t)u.kc * 2048 * 1024;
        EPI_LOOP({ float* o = pb + (size_t)(row - TP) * 1024 + col; *(f32x4*)o = v0; *(f32x4*)(o + 4) = v1; })
    }
};
struct SplitOrder {
    int G, c;
    __device__ __forceinline__ bool next(int i, Unit& u) const { const int L = i * G + c; if (L >= 256) return false; u.pm = 128 + (L >> 5); const int r = L & 31; u.pn = r >> 3; u.kc = r & 7; return true; }
    __device__ __forceinline__ void a_ready(const Unit&) const {}
    __device__ __forceinline__ void done(const Unit&) const {}
};
__device__ __forceinline__ float wave_sum(float v) {
#pragma unroll
    for (int o = 1; o < 64; o <<= 1) v += __shfl_xor(v, o);
    return v;
}
__device__ __forceinline__ void transpose_item(const float* __restrict__ W, int K, int N, const float* __restrict__ kscale, bf16_t* WT, LAS float* scr, int item, int lane) {
    const int nblk = N / 32, kb = item / nblk, nb = item % nblk, k0 = 64 * kb, n0 = 32 * nb;
#pragma unroll 8
    for (int i = 0; i < 32; ++i) { const int kk = 2 * i + (lane >> 5); float v = W[(size_t)(k0 + kk) * N + n0 + (lane & 31)]; if (kscale) v *= kscale[k0 + kk]; scr[kk * 33 + (lane & 31)] = v; }
    LDS_FENCE();
    const int c = lane & 7;
#pragma unroll
    for (int j = 0; j < 4; ++j) { const int n = (lane >> 3) + 8 * j; const LAS float* s = scr + (8 * c) * 33 + n;
        u32x4 o; o.x = pk2(s[0 * 33], s[1 * 33]); o.y = pk2(s[2 * 33], s[3 * 33]); o.z = pk2(s[4 * 33], s[5 * 33]); o.w = pk2(s[6 * 33], s[7 * 33]);
        *(u32x4*)(WT + (size_t)(n0 + n) * K + k0 + 8 * c) = o; }
    LDS_FENCE();
}

struct LruP { const bf16_t *XL, *GG, *WRt, *WIt; bf16_t* BO; bf16_t *LA, *U; float* AGG; const float* CARRY; const float *conv_w, *conv_b, *b_r, *b_i, *lam, *state_conv, *state_lru; float* out; };
template <bool FINAL>
__device__ __forceinline__ void lru_item(const LruP& p, LAS char* scr, int tl, int n, int lane) {
    const int l31 = lane & 31, hi = lane >> 5;
    const bool samp = tl >= 512; const int bs = tl - 512, c = tl & 127, bp = tl >> 7;
    const size_t tok0 = (size_t)tl * 64;
    LAS bf16_t* sx = (LAS bf16_t*)scr;
    const unsigned lvoff = (unsigned)((4 * hi * 1024 + l31) * 2);
    {
        const int ch = n * 64 + lane;
        const float w0 = p.conv_w[ch], w1 = p.conv_w[1024 + ch], w2 = p.conv_w[2048 + ch], w3 = p.conv_w[3072 + ch], cb = p.conv_b[ch];
        float x0, x1, x2;
        if (samp) { x0 = p.state_conv[(size_t)(bs * 3 + 0) * 1024 + ch]; x1 = p.state_conv[(size_t)(bs * 3 + 1) * 1024 + ch]; x2 = p.state_conv[(size_t)(bs * 3 + 2) * 1024 + ch]; }
        else if (c == 0) { x0 = 0.f; x1 = 0.f; x2 = 0.f; }
        else { x0 = bf2f(p.XL[(tok0 - 3) * 1024 + ch]); x1 = bf2f(p.XL[(tok0 - 2) * 1024 + ch]); x2 = bf2f(p.XL[(tok0 - 1) * 1024 + ch]); }
        LAS char* raw = scr + 9216;
        { const char* gx = (const char*)(p.XL + tok0 * 1024 + n * 64); const unsigned go = (unsigned)((lane >> 3) * 2048 + (lane & 7) * 16);
          u32x4 v[8];
#pragma unroll
          for (int i = 0; i < 8; ++i) v[i] = *(const u32x4*)(gx + (size_t)i * 8 * 2048 + go);
#pragma unroll
          for (int i = 0; i < 8; ++i) *(LAS u32x4*)(raw + ((lane >> 3) + 8 * i) * 128 + (lane & 7) * 16) = v[i]; }
        LDS_FENCE();
#pragma unroll 16
        for (int t = 0; t < 64; ++t) { const float x3 = bf2f(*(const LAS bf16_t*)(raw + t * 128 + lane * 2)); const float xc = cb + w0 * x0 + w1 * x1 + w2 * x2 + w3 * x3; sx[t * 72 + lane] = f2bf(xc); x0 = x1; x1 = x2; x2 = x3; }
    }
    LDS_FENCE();
    for (int nt = 0; nt < 2; ++nt) {
        const int chd = n * 64 + 32 * nt + l31;
        f32x16 R[2], I[2];
#pragma unroll
        for (int r = 0; r < 16; ++r) { R[0][r] = 0.f; R[1][r] = 0.f; I[0][r] = 0.f; I[1][r] = 0.f; }
#pragma unroll
        for (int kk = 0; kk < 4; ++kk) {
            const bf16x8 br = *(const bf16x8*)(p.WRt + (size_t)chd * 64 + 16 * kk + 8 * hi);
            const bf16x8 bi = *(const bf16x8*)(p.WIt + (size_t)chd * 64 + 16 * kk + 8 * hi);
#pragma unroll
            for (int mt = 0; mt < 2; ++mt) { const bf16x8 a = *(const LAS bf16x8*)(scr + (32 * mt + l31) * 144 + (16 * kk + 8 * hi) * 2); R[mt] = MFMA32(a, br, R[mt]); I[mt] = MFMA32(a, bi, I[mt]); }
        }
        const float brv = p.b_r[chd], biv = p.b_i[chd];
        const float sp8 = -8.0f * log1pf(__expf(-p.lam[chd]));
#pragma unroll
        for (int mt = 0; mt < 2; ++mt)
#pragma unroll
            for (int r = 0; r < 16; ++r) { const int t = 32 * mt + crow(r, hi); const float xcv = bf2f(sx[t * 72 + 32 * nt + l31]);
                const float rg = fsigmoid(R[mt][r] + brv), ig = fsigmoid(I[mt][r] + biv);
                const bf16_t lab = f2bf(rg * sp8); const float la = bf2f(lab), av = __builtin_amdgcn_exp2f(la * 1.4426950408889634f), x2 = 2.0f * la;
                const float ser = -x2 * (1.0f + x2 * (0.5f + x2 * (0.16666667f + x2 * (0.041666668f + x2 * 0.008333334f))));
                const float om = (x2 > -0.25f) ? ser : (1.0f - av * av);
                const bf16_t ub16 = f2bf(__builtin_amdgcn_sqrtf(om) * ig * xcv);
                R[mt][r] = av; I[mt][r] = bf2f(ub16);
                if (!FINAL) { const size_t ub = ((tok0 + 32 * mt + (r & 3) + 8 * (r >> 2)) * 1024 + n * 64 + 32 * nt) * 2;
                    *(bf16_t*)((char*)p.LA + ub + lvoff) = lab; *(bf16_t*)((char*)p.U + ub + lvoff) = ub16; } }
        float oA[8], oH[8], pA[8], pH[8];
#pragma unroll
        for (int gi = 0; gi < 8; ++gi) { float A = 1.f, H = 0.f;
#pragma unroll
            for (int j = 0; j < 4; ++j) { const float a = R[gi >> 2][(gi & 3) * 4 + j]; H = a * H + I[gi >> 2][(gi & 3) * 4 + j]; A *= a; }
            oA[gi] = A; oH[gi] = H; pA[gi] = __shfl_xor(A, 32); pH[gi] = __shfl_xor(H, 32); }
        float h = 0.f;
        if (FINAL) {
            if (samp) h = p.state_lru[(size_t)bs * 1024 + chd];
            else h = p.CARRY[(size_t)tl * 1024 + chd];
        }
        float cin[8], Atot = 1.f;
#pragma unroll
        for (int k = 0; k < 8; ++k) { const float Alo = hi ? pA[k] : oA[k], Hlo = hi ? pH[k] : oH[k], Ahi = hi ? oA[k] : pA[k], Hhi = hi ? oH[k] : pH[k];
            const float hm = Alo * h + Hlo; cin[k] = hi ? hm : h; h = Ahi * hm + Hhi; Atot *= Alo * Ahi; }
        if (!FINAL) { if (hi == 0 && !samp) { p.AGG[(size_t)tl * 2048 + chd] = Atot; p.AGG[(size_t)tl * 2048 + 1024 + chd] = h; } }
        else {
#pragma unroll
            for (int gi = 0; gi < 8; ++gi) { float hh = cin[gi];
#pragma unroll
                for (int j = 0; j < 4; ++j) { const int r = (gi & 3) * 4 + j, mt = gi >> 2; hh = R[mt][r] * hh + I[mt][r]; const size_t ub = ((tok0 + 32 * mt + (r & 3) + 8 * (r >> 2)) * 1024 + n * 64 + 32 * nt) * 2;
                    *(bf16_t*)((char*)p.BO + ub + lvoff) = f2bf(hh * bf2f(*(const bf16_t*)((const char*)p.GG + ub + lvoff))); } }
            if (hi == 0) { if (samp) p.out[O_LS + (size_t)bs * 1024 + chd] = h; else if (c == 127) p.out[O_LP + (size_t)bp * 1024 + chd] = h; }
        }
    }
    LDS_FENCE();
}

__device__ __forceinline__ void lru_final_light(const LruP& p, int tl, int n, int lane) {
    const bool samp = tl >= 512; const int bs = tl - 512, c = tl & 127, bp = tl >> 7; const size_t tok0 = (size_t)tl * 64;
    const int ch = n * 64 + lane; const unsigned l2 = (unsigned)lane * 2u;
    float h = samp ? p.state_lru[(size_t)bs * 1024 + ch] : p.CARRY[(size_t)tl * 1024 + ch];
#pragma unroll 16
    for (int t = 0; t < 64; ++t) { const size_t ub = ((tok0 + t) * 1024 + n * 64) * 2;
        const float la = bf2f(*(const bf16_t*)((const char*)p.LA + ub + l2)), u = bf2f(*(const bf16_t*)((const char*)p.U + ub + l2)), gg = bf2f(*(const bf16_t*)((const char*)p.GG + ub + l2));
        h = __builtin_amdgcn_exp2f(la * 1.4426950408889634f) * h + u;
        *(bf16_t*)((char*)p.BO + ub + l2) = f2bf(h * gg); }
    if (samp) p.out[O_LS + (size_t)bs * 1024 + ch] = h; else if (c == 127) p.out[O_LP + (size_t)bp * 1024 + ch] = h;
}
constexpr int AT_KB = 16384, AT_BUF = 32768, AT_EXCH = 2 * AT_BUF, AT_WSF = AT_EXCH + 65536;
static_assert(AT_WSF + 2048 <= LDS_BYTES, "attention LDS map");
typedef short v4i16_t __attribute__((ext_vector_type(4)));
struct AttP { const bf16_t *Q, *Kb, *VT; bf16_t* AO; const float *cache_k, *cache_v, *head_gain; int flags; };
template <bool SAMPLE>
__device__ __forceinline__ void attn_unit(const AttP& p, LAS char* lds, int b, int h, int qb, float lam) {
    const int tid = threadIdx.x, lane = tid & 63, l31 = lane & 31, hi = lane >> 5;
    const int w = __builtin_amdgcn_readfirstlane(tid >> 6), c = w >> 2, wq = w & 3;
    const size_t tok0 = SAMPLE ? (size_t)(TP + b * 64) : (size_t)b * SEQP;
    const int q0 = SAMPLE ? 0 : qb * 128;
    const int NT = SAMPLE ? 17 : 2 * qb + 2;
    const bool active = SAMPLE ? (wq < 2) : true;
    const int myNT = SAMPLE ? 17 : (wq < 2 ? NT - 1 : NT);
    LAS float* wsf = (LAS float*)(lds + AT_WSF) + w * 64;
    const int kfo = l31 * 256, kfx = (c * 8 + hi) ^ (l31 & 15);
    const int vq = (lane & 15) >> 2, vfo = (4 * hi + vq) * 256 + ((lane >> 4) & 1) * 32 + (lane & 3) * 8;
    const unsigned aovoff = (unsigned)((4 * hi * 1024 + l31) * 2);
    bf16x8 qf[4];
    { const bf16_t* qp = p.Q + (tok0 + q0 + (active ? wq : 0) * 32 + l31) * 1024 + h * 128 + c * 64 + hi * 8;
#pragma unroll
      for (int d0 = 0; d0 < 4; ++d0) qf[d0] = *(const bf16x8*)(qp + d0 * 16); }
    f32x16 O[4];
#pragma unroll
    for (int dt = 0; dt < 4; ++dt)
#pragma unroll
        for (int r = 0; r < 16; ++r) O[dt][r] = 0.f;
    float mrun = 0.f, lrun = 0.f;
    u32x4 st[4];
    if (!SAMPLE) { st[0] = st[1] = st[2] = st[3] = (u32x4){0u, 0u, 0u, 0u}; }
    const unsigned coff_l = (unsigned)(((tid >> 5) * 1024 + (tid & 31) * 4) * 4);
    unsigned ksrc[2], vsrc[2];
#pragma unroll
    for (int i = 0; i < 2; ++i) { const int row = 4 * (w * 2 + i) + (lane >> 4), chp = lane & 15;
        ksrc[i] = (unsigned)((row * 1024 + (chp ^ (row & 15)) * 8) * 2); vsrc[i] = (unsigned)((row * 1024 + (chp ^ ((row & 3) << 2)) * 8) * 2); }
#define DMA_K(trow_, buf_) do { const char* gk_ = (const char*)(p.Kb + (size_t)(trow_) * 1024 + h * 128); _Pragma("unroll") for (int i = 0; i < 2; ++i) \
            __builtin_amdgcn_global_load_lds((const unsigned*)(gk_ + ksrc[i]), (LAS unsigned*)(lds + (buf_) * AT_BUF + (w * 2 + i) * 1024), 16, 0, 0); } while (0)
#define DMA_V(trow_, buf_) do { const char* gv_ = (const char*)(p.VT + (size_t)(trow_) * 1024 + h * 128); _Pragma("unroll") for (int i = 0; i < 2; ++i) \
            __builtin_amdgcn_global_load_lds((const unsigned*)(gv_ + vsrc[i]), (LAS unsigned*)(lds + (buf_) * AT_BUF + AT_KB + (w * 2 + i) * 1024), 16, 0, 0); } while (0)
#define LOAD_F32(src_, t_) do { _Pragma("unroll") for (int i = 0; i < 4; ++i) { \
            st[i] = *(const u32x4*)((const char*)((src_) + (((size_t)b * 1024 + (t_) * 64 + 16 * i) * 8 + h) * 128) + coff_l); } } while (0)
#define STORE_F32(buf_, boff_, isv_) do { LAS char* kb_ = lds + (buf_) * AT_BUF + (boff_); _Pragma("unroll") for (int i = 0; i < 4; ++i) { const int id = tid + 512 * i; const int row = id >> 5, c4 = id & 31; \
            u32x2 kk; kk.x = pk2(__uint_as_float(st[i][0]), __uint_as_float(st[i][1])); kk.y = pk2(__uint_as_float(st[i][2]), __uint_as_float(st[i][3])); \
            const int sw_ = (isv_) ? ((row & 3) << 2) : (row & 15); \
            *(LAS u32x2*)(kb_ + row * 256 + (((c4 >> 1) ^ sw_) << 4) + (c4 & 1) * 8) = kk; } } while (0)
    if (SAMPLE) { LOAD_F32(p.cache_k, 0); STORE_F32(0, 0, 0); } else { DMA_K(tok0, 0); }
    __syncthreads();
    mrun = 0.f;
    bf16x8 pa0, pa1, pa2, pa3;
    pa0 = pa1 = pa2 = pa3 = (bf16x8){0, 0, 0, 0, 0, 0, 0, 0};
#define VLOAD(dst_, s_) do { _Pragma("unroll") for (int dt = 0; dt < 4; ++dt) { LAS char* vp = vb + vfo + ((dt ^ vq) << 6) + (16 * (s_)) * 256; \
                    const v4i16_t lo_ = __builtin_amdgcn_ds_read_tr16_b64_v4i16((LAS v4i16_t*)vp), hh_ = __builtin_amdgcn_ds_read_tr16_b64_v4i16((LAS v4i16_t*)(vp + 8 * 256)); \
                    dst_[dt] = __builtin_shufflevector(lo_, hh_, 0, 1, 2, 3, 4, 5, 6, 7); } } while (0)
#define PKP(P_, q_) __builtin_bit_cast(bf16x8, (u32x4){pk2(P_[8 * q_ + 0], P_[8 * q_ + 1]), pk2(P_[8 * q_ + 2], P_[8 * q_ + 3]), pk2(P_[8 * q_ + 4], P_[8 * q_ + 5]), pk2(P_[8 * q_ + 6], P_[8 * q_ + 7])})
#define PVMM(pa_, vf_) do { _Pragma("unroll") for (int dt = 0; dt < 4; ++dt) O[dt] = MFMA32(pa_, vf_[dt], O[dt]); } while (0)
#define PV_ALL() do { bf16x8 va[4]; VLOAD(va, 0); PVMM(pa0, va); VLOAD(va, 1); PVMM(pa1, va); VLOAD(va, 2); PVMM(pa2, va); VLOAD(va, 3); PVMM(pa3, va); } while (0)
#define QK_MAX(t_, kb_) \
            const bool maskt = !SAMPLE && ((t_) >= myNT);        \
            f32x16 p0, p1; \
            _Pragma("unroll") for (int r = 0; r < 16; ++r) { p0[r] = 0.f; p1[r] = 0.f; } \
            _Pragma("unroll") for (int d0 = 0; d0 < 4; ++d0) { \
                const bf16x8 k0 = *(const LAS bf16x8*)((kb_) + kfo + ((kfx ^ (d0 << 1)) << 4)); \
                const bf16x8 k1 = *(const LAS bf16x8*)((kb_) + kfo + 8192 + ((kfx ^ (d0 << 1)) << 4)); \
                p0 = MFMA32(k0, qf[d0], p0); p1 = MFMA32(k1, qf[d0], p1); } \
            __builtin_amdgcn_sched_group_barrier(0x100, 4, 0); \
            _Pragma("unroll") for (int i_ = 0; i_ < 2; ++i_) { __builtin_amdgcn_sched_group_barrier(0x008, 1, 0); __builtin_amdgcn_sched_group_barrier(0x100, 2, 0); } \
            __builtin_amdgcn_sched_group_barrier(0x008, 6, 0); \
            float rm = fmaxf(fmaxf(p0[0], p1[0]), p0[1]); \
            _Pragma("unroll") for (int r = 2; r < 16; r += 2) rm = fmaxf(fmaxf(rm, p0[r]), p0[r + 1]); \
            _Pragma("unroll") for (int r = 1; r < 16; r += 2) rm = fmaxf(fmaxf(rm, p1[r]), p1[(r + 1) & 15]); \
            rm = fmaxf(rm, __shfl_xor(rm, 32)) - mrun; \
            if (maskt) rm = 0.f; \
            const bool resc = __any(rm > 8.0f) || (t_) == 0;     \
            float alpha = 1.0f; \
            if (resc) { const float dl = (rm > 8.0f || (t_) == 0) ? rm : 0.f; alpha = __builtin_amdgcn_exp2f(-dl); mrun += dl; lrun *= alpha; } \
            const float sh = maskt ? 1e30f : mrun; \
            _Pragma("unroll") for (int r = 0; r < 16; ++r) { p0[r] -= sh; p1[r] -= sh; } \
            __builtin_amdgcn_sched_barrier(0);
#define O_RESCALE() do { if (resc) { if (hi == 0) wsf[l31] = alpha; LDS_FENCE(); \
                _Pragma("unroll") for (int r = 0; r < 16; ++r) { const float a_ = wsf[crow(r, hi)]; _Pragma("unroll") for (int dt = 0; dt < 4; ++dt) O[dt][r] *= a_; } LDS_FENCE(); } } while (0)
    if (!SAMPLE) { DMA_K(tok0 + 64, 1); DMA_V(tok0, 0); }
    if (active) {
        QK_MAX(0, lds)
        float ls = 0.f;
#pragma unroll
        for (int r = 0; r < 16; ++r) { p0[r] = __builtin_amdgcn_exp2f(p0[r]); p1[r] = __builtin_amdgcn_exp2f(p1[r]); ls += p0[r] + p1[r]; }
        lrun += ls;
        pa0 = PKP(p0, 0); pa1 = PKP(p0, 1); pa2 = PKP(p1, 0); pa3 = PKP(p1, 1);
    }
    if (SAMPLE) { LOAD_F32(p.cache_k, 1); STORE_F32(1, 0, 0); LOAD_F32(p.cache_v, 0); STORE_F32(0, AT_KB, 1); }
    __syncthreads();
    for (int t = 1; t < NT; ++t) {
        const int buf = t & 1;
        if (!SAMPLE) { if (t + 1 < NT) DMA_K(tok0 + (size_t)(t + 1) * 64, buf ^ 1); DMA_V(tok0 + (size_t)t * 64, buf); }
        else { if (t + 1 == 16) DMA_K(tok0, buf ^ 1); if (t == 16) DMA_V(tok0, buf); }
        LAS char* vb = lds + (buf ^ 1) * AT_BUF + AT_KB;
        if (active) {
            QK_MAX(t, lds + buf * AT_BUF)
            float ls = 0.f;
            bf16x8 va[4];
#define EXP8(P_, q_) do { _Pragma("unroll") for (int r = 8 * (q_); r < 8 * (q_) + 8; ++r) { P_[r] = __builtin_amdgcn_exp2f(P_[r]); ls += P_[r]; } } while (0)
            VLOAD(va, 0); EXP8(p0, 0); PVMM(pa0, va); pa0 = PKP(p0, 0);
            VLOAD(va, 1); EXP8(p0, 1); PVMM(pa1, va); pa1 = PKP(p0, 1);
            VLOAD(va, 2); EXP8(p1, 0); PVMM(pa2, va); pa2 = PKP(p1, 0);
            VLOAD(va, 3); EXP8(p1, 1); PVMM(pa3, va); pa3 = PKP(p1, 1);
#undef EXP8
            __builtin_amdgcn_sched_group_barrier(0x100, 8, 0); __builtin_amdgcn_sched_group_barrier(0x002, 8, 0);
#pragma unroll
            for (int i_ = 0; i_ < 8; ++i_) { __builtin_amdgcn_sched_group_barrier(0x008, 1, 0); __builtin_amdgcn_sched_group_barrier(0x100, 2, 0); __builtin_amdgcn_sched_group_barrier(0x002, 5, 0); }
#pragma unroll
            for (int i_ = 0; i_ < 4; ++i_) { __builtin_amdgcn_sched_group_barrier(0x008, 1, 0); __builtin_amdgcn_sched_group_barrier(0x100, 2, 0); __builtin_amdgcn_sched_group_barrier(0x002, 4, 0); }
#pragma unroll
            for (int i_ = 0; i_ < 4; ++i_) { __builtin_amdgcn_sched_group_barrier(0x008, 1, 0); __builtin_amdgcn_sched_group_barrier(0x002, 4, 0); }
            lrun += ls;
            O_RESCALE();
        }
        if (SAMPLE) { if (t + 1 < 16) { LOAD_F32(p.cache_k, t + 1); STORE_F32(buf ^ 1, 0, 0); } if (t < 16) { LOAD_F32(p.cache_v, t); STORE_F32(buf, AT_KB, 1); } }
        __syncthreads();
    }
    if (active) { LAS char* vb = lds + ((NT - 1) & 1) * AT_BUF + AT_KB; PV_ALL(); }
    __syncthreads();
#undef QK_MAX
#undef O_RESCALE
#undef VLOAD
#undef PKP
#undef PVMM
#undef PV_ALL
    if (active) {
        const float lt = lrun + __shfl_xor(lrun, 32);
        const float sc = (c == 0 ? 1.0f : lam) * __builtin_amdgcn_rcpf(lt);
        if (hi == 0) wsf[l31] = sc;
        LDS_FENCE();
#pragma unroll
        for (int r = 0; r < 16; ++r) { const float a = wsf[crow(r, hi)];
#pragma unroll
            for (int dt = 0; dt < 4; ++dt) O[dt][r] *= a; }
        LDS_FENCE();
    }
    LAS float* ex = (LAS float*)(lds + AT_EXCH) + wq * 4096;
    if (active && c == 1) {
#pragma unroll
        for (int dt = 0; dt < 4; ++dt)
#pragma unroll
            for (int r = 0; r < 16; ++r) ex[(dt * 16 + r) * 64 + lane] = O[dt][r];
    }
    __syncthreads();
    if (active && c == 0) {
        float hg[4];
#pragma unroll
        for (int dt = 0; dt < 4; ++dt) hg[dt] = p.head_gain[32 * dt + l31] * 0.8f;
#pragma unroll
        for (int r = 0; r < 16; ++r) {
            float o[4], ss = 0.f;
#pragma unroll
            for (int dt = 0; dt < 4; ++dt) { o[dt] = O[dt][r] - ex[(dt * 16 + r) * 64 + lane]; ss += o[dt] * o[dt]; }
            ss += __shfl_xor(ss, 1); ss += __shfl_xor(ss, 2); ss += __shfl_xor(ss, 4); ss += __shfl_xor(ss, 8); ss += __shfl_xor(ss, 16);
            const float rs = __builtin_amdgcn_rsqf(ss * (1.0f / 128.0f) + EPS);
            char* op = (char*)(p.AO + (tok0 + q0 + wq * 32 + (r & 3) + 8 * (r >> 2)) * 1024 + h * 128);
#pragma unroll
            for (int dt = 0; dt < 4; ++dt) *(bf16_t*)(op + 64 * dt + aovoff) = f2bf(o[dt] * rs * hg[dt]);
        }
    }
    __syncthreads();
}

#define XB_TMO      128
#define XB_XCNT(j)  (256  + 64 * (j))
#define XB_XSUB(j)  (1280 + 64 * (j))
#define XB_XGEN(j)  (2304 + 64 * (j))
#define XB_TOP      3328
#define XB_TOPGEN   3392
#define XCD_BAR_WORDS 3456
#define XB_SPIN_CAP (1u << 18)

__device__ __forceinline__ unsigned xb_ld(unsigned* p)              { return __hip_atomic_load(p, __ATOMIC_RELAXED, __HIP_MEMORY_SCOPE_AGENT); }
__device__ __forceinline__ unsigned xb_add(unsigned* p, unsigned v) { return __hip_atomic_fetch_add(p, v, __ATOMIC_RELAXED, __HIP_MEMORY_SCOPE_AGENT); }
__device__ __forceinline__ unsigned xb_xcc_id() { return (unsigned)__builtin_amdgcn_s_getreg((3 << 11) | 20) & 0xFu; }
#define XB_SPIN(cond, bar) do { unsigned _sp = 0; while (cond) { __builtin_amdgcn_s_sleep(1); \
    if ((++_sp & 255u) == 0u) { if (xb_ld(&(bar)[XB_TMO])) break; if (_sp > XB_SPIN_CAP) { atomicAdd(&(bar)[XB_TMO], 1u); break; } } } } while (0)

struct XcdBarrier {
    unsigned* bar; unsigned x;
    volatile LAS unsigned* st;
};

__device__ __forceinline__ XcdBarrier xcd_barrier_post(unsigned* bar, volatile LAS unsigned* st) {
    XcdBarrier b; b.bar = bar; b.x = xb_xcc_id(); b.st = st;
    if (threadIdx.x == 0) (void)xb_add(&bar[XB_XCNT(b.x)], 1u);
    return b;
}
__device__ __forceinline__ void xcd_barrier_complete(unsigned* bar, unsigned x, unsigned& nloc, unsigned& nx) {
    const unsigned G = gridDim.x * gridDim.y * gridDim.z;
    unsigned sum, cnt, mine, sp = 0u;
    for (;;) {
        sum = 0u; cnt = 0u; mine = 0u;
#pragma unroll
        for (unsigned j = 0; j < 16; ++j) { const unsigned c = xb_ld(&bar[XB_XCNT(j)]); sum += c; cnt += (c > 0u) ? 1u : 0u; mine = (j == x) ? c : mine; }
        if (sum == G) break;
        __builtin_amdgcn_s_sleep(1);
        if ((++sp & 255u) == 0u) { if (xb_ld(&bar[XB_TMO])) break; if (sp > XB_SPIN_CAP) { atomicAdd(&bar[XB_TMO], 1u); break; } }
    }
    nloc = mine > 0u ? mine : 1u; nx = cnt > 0u ? cnt : 1u;
}

__device__ __forceinline__ void xcd_barrier(const XcdBarrier& b) {
    asm volatile("s_waitcnt vmcnt(0)" ::: "memory");
    __syncthreads();
    if (threadIdx.x == 0) {
        unsigned* bar = b.bar;
        __builtin_amdgcn_s_waitcnt(0);
        unsigned nloc = b.st[0], nx = b.st[1];
        if (nloc == 0u) { xcd_barrier_complete(bar, b.x, nloc, nx); b.st[0] = nloc; b.st[1] = nx; }
        const unsigned old = xb_add(&bar[XB_XSUB(b.x)], 1u);
        const unsigned gen = old / nloc;
        if (old + 1u == (gen + 1u) * nloc) {
            __builtin_amdgcn_fence(__ATOMIC_RELEASE, "agent");
            asm volatile("s_waitcnt vmcnt(0)" ::: "memory");
            const unsigned og = xb_add(&bar[XB_TOP], 1u);
            const unsigned tg = og / nx;
            if (og + 1u == (tg + 1u) * nx) xb_add(&bar[XB_TOPGEN], 1u);
            else XB_SPIN(xb_ld(&bar[XB_TOPGEN]) == tg, bar);
            __builtin_amdgcn_fence(__ATOMIC_ACQUIRE, "agent");
            xb_add(&bar[XB_XGEN(b.x)], 1u);
            asm volatile("s_waitcnt vmcnt(0)" ::: "memory");
        } else {
            XB_SPIN(xb_ld(&bar[XB_XGEN(b.x)]) == gen, bar);
            __builtin_amdgcn_fence(__ATOMIC_ACQUIRE, "agent");
            asm volatile("s_waitcnt vmcnt(0)" ::: "memory");
        }
    }
    __syncthreads();
}


__device__ __forceinline__ void grid_bar(unsigned* cnt, unsigned target) {
    asm volatile("s_waitcnt vmcnt(0)" ::: "memory");
    __syncthreads();
    if (threadIdx.x == 0) {
        __builtin_amdgcn_fence(__ATOMIC_RELEASE, "agent");
        asm volatile("s_waitcnt vmcnt(0)" ::: "memory");
        __hip_atomic_fetch_add(cnt, 1u, __ATOMIC_RELAXED, __HIP_MEMORY_SCOPE_AGENT);
        while (__hip_atomic_load(cnt, __ATOMIC_RELAXED, __HIP_MEMORY_SCOPE_AGENT) < target) __builtin_amdgcn_s_sleep(2);
        __builtin_amdgcn_fence(__ATOMIC_ACQUIRE, "agent");
        asm volatile("s_waitcnt vmcnt(0)" ::: "memory");
    }
    __syncthreads();
}
__global__ void __launch_bounds__(512, 2) mega(Args a) {
    extern __shared__ __attribute__((aligned(16))) unsigned char lds_raw[];
    LAS unsigned char* lds = (LAS unsigned char*)lds_raw;
    const int tid = threadIdx.x, lane = tid & 63, wave = __builtin_amdgcn_readfirstlane(tid >> 6);
    const int G = gridDim.x, bx = blockIdx.x;
    const int vcu = (G % 8 == 0) ? (bx % 8) * (G / 8) + bx / 8 : bx;
    const int gw = vcu * 8 + wave, NGW = G * 8;
    unsigned char* ws = a.ws;
    bf16_t* WinT = (bf16_t*)(ws + WS_WIN); bf16_t* WbaT = (bf16_t*)(ws + WS_WBA); bf16_t* WblT = (bf16_t*)(ws + WS_WBL); bf16_t* WoT = (bf16_t*)(ws + WS_WO);
    bf16_t* WupT = (bf16_t*)(ws + WS_WUP); bf16_t* WdnT = (bf16_t*)(ws + WS_WDN); bf16_t* WRt = (bf16_t*)(ws + WS_WR); bf16_t* WIt = (bf16_t*)(ws + WS_WI);
    float* AGG = (float*)(ws + WS_AGG); float* RSS = (float*)(ws + WS_RSS);
    bf16_t* S0 = (bf16_t*)(ws + WS_SLOT0); bf16_t* S1 = (bf16_t*)(ws + WS_SLOT0 + SLOT); bf16_t* S2 = (bf16_t*)(ws + WS_SLOT0 + 2 * SLOT); bf16_t* S3 = (bf16_t*)(ws + WS_SLOT0 + 3 * SLOT);
    bf16_t* S4 = (bf16_t*)(ws + WS_SLOT0 + 4 * SLOT); bf16_t* S5 = (bf16_t*)(ws + WS_SLOT0 + 5 * SLOT);
    bf16_t *XN = S0, *BO = S0, *Qb = S1, *AO = S1, *Kb = S2, *MG = S2, *VT = S3, *TMP = S4, *XL = S4, *GG = S5, *HB = S5, *UP = S0;
    bf16_t* GA = (bf16_t*)(a.out + O_Y); bf16_t* GB = GA + (size_t)T * 1024;
    float* H = a.out + O_Y;
    const int lo = a.ph_lo, hi_ph = a.ph_hi;
#ifdef ONLYPH
#define IN(k) ((k) == ONLYPH && lo <= (k) && (k) < hi_ph)
#else
#define IN(k) (lo <= (k) && (k) < hi_ph)
#endif
    unsigned* barcnt = (unsigned*)(ws + WS_CTL);
    volatile LAS unsigned* xst = (volatile LAS unsigned*)(lds + LDS_BYTES - 16);
    if (tid < 2) xst[tid] = 0u;
    __syncthreads();
    const XcdBarrier xbar = xcd_barrier_post((unsigned*)(ws + WS_XB), xst);
    if (a.ph_lo < 0) cg::this_grid().sync();
#define SYNC(k) do { if (IN(k) && IN((k) + 1)) xcd_barrier(xbar); } while (0)

    if (IN(0)) for (int rep = 0; rep < REPN(0); ++rep) {
        LAS float* scr = (LAS float*)(lds + wave * 16384);
        constexpr int I_IN = 16 * 224, I_SQ = 16 * 32, I_UP = 16 * 128, I_DN = 64 * 32, I_G = 32;
        constexpr int NIT = I_IN + 3 * I_SQ + I_UP + I_DN + 2 * I_G;
        for (int it = gw; it < NIT; it += NGW) {
            int r = it;
            if (r < I_IN) { transpose_item(a.w_in, 1024, NIN, nullptr, WinT, scr, r, lane); continue; } r -= I_IN;
            if (r < I_SQ) { transpose_item(a.w_ba, 1024, 1024, nullptr, WbaT, scr, r, lane); continue; } r -= I_SQ;
            if (r < I_SQ) { transpose_item(a.w_bl, 1024, 1024, nullptr, WblT, scr, r, lane); continue; } r -= I_SQ;
            if (r < I_SQ) { transpose_item(a.w_o, 1024, 1024, nullptr, WoT, scr, r, lane); continue; } r -= I_SQ;
            if (r < I_UP) { transpose_item(a.w_up, 1024, FF, a.norm_mlp, WupT, scr, r, lane); continue; } r -= I_UP;
            if (r < I_DN) { transpose_item(a.w_down, FF, 1024, nullptr, WdnT, scr, r, lane); continue; } r -= I_DN;
            if (r < I_G) { transpose_item(a.w_rgate + (size_t)(r >> 1) * 4096, 64, 64, nullptr, WRt + (size_t)(r >> 1) * 4096, scr, r & 1, lane); continue; } r -= I_G;
            transpose_item(a.w_igate + (size_t)(r >> 1) * 4096, 64, 64, nullptr, WIt + (size_t)(r >> 1) * 4096, scr, r & 1, lane);
        }
        f32x4 g[4];
#pragma unroll
        for (int j = 0; j < 4; ++j) g[j] = ((const f32x4*)a.norm_mix)[lane + 64 * j];
        for (int m = gw; m < T; m += NGW) {
            const float* xr = (m < TP) ? a.x_prompt + (size_t)m * 1024 : a.x_sample + (size_t)(m - TP) * 1024;
            f32x4 v[4]; float s = 0.f;
#pragma unroll
            for (int j = 0; j < 4; ++j) { v[j] = ((const f32x4*)xr)[lane + 64 * j]; s += (v[j][0] * v[j][0] + v[j][1] * v[j][1]) + (v[j][2] * v[j][2] + v[j][3] * v[j][3]); }
            const float rstd = 1.0f / sqrtf(wave_sum(s) * (1.0f / 1024.0f) + EPS);
            u32x2* o = (u32x2*)(XN + (size_t)m * 1024);
#pragma unroll
            for (int j = 0; j < 4; ++j) { u32x2 w2; w2.x = pk2(v[j][0] * rstd * g[j][0], v[j][1] * rstd * g[j][1]); w2.y = pk2(v[j][2] * rstd * g[j][2], v[j][3] * rstd * g[j][3]); o[lane + 64 * j] = w2; }
        }
    }
    SYNC(0);
    if (IN(1)) for (int rep = 0; rep < REPN(1); ++rep) {
        pg8::Gemm g{XN, WinT, T, NIN, 1024, 1024}; pg8::StaticOrder S; S.init(T, NIN, G, bx);
        EpiIn E{Qb, Kb, VT, XL, GG, GA, GB, a.out};
        pg8::gemm_phase<EpiIn, pg8::StaticOrder, true, true>(lds, g, S, E);
    }
    SYNC(1);
    float* CARRY = (float*)(ws + WS_CARRY);
    LruP lp{XL, GG, WRt, WIt, BO, S2, S3, AGG, CARRY, a.conv_w, a.conv_b, a.b_rgate, a.b_igate, a.lru_lambda, a.state_conv, a.state_lru, a.out};
    if (IN(2)) {
        float lam;
        { const float q0 = a.lambda_q[lane], k0 = a.lambda_k[lane], q1 = a.lambda_q[64 + lane], k1 = a.lambda_k[64 + lane];
          lam = __expf(wave_sum(q0 * k0)) - __expf(wave_sum(q1 * k1)) + 0.2f; }
        AttP ap{Qb, Kb, VT, AO, a.cache_k, a.cache_v, a.head_gain, a.flags};
        { const int nsamp = (vcu < 256) ? (255 - vcu) / G + 1 : 0, npr = (vcu < 1024) ? 2 * ((1023 - vcu) / G + 1) : 0;
          const int ss = nsamp ? (vcu % (npr + 1)) : -1;
          int si = 0, pi = 0;
          for (int k = 0; k < npr + nsamp; ++k) {
              const bool is_s = (si < nsamp) && (k == ss || pi >= npr);
              if (is_s) { const int u = vcu + si * G; attn_unit<true>(ap, (LAS char*)lds, u >> 3, u & 7, 0, lam); ++si; }
              else { const int pr = vcu + (pi >> 1) * G, bh = pr >> 5, s = pr & 31; attn_unit<false>(ap, (LAS char*)lds, bh >> 3, bh & 7, (pi & 1) ? s : 63 - s, lam); ++pi; } } }
    }
    SYNC(2);
    if (IN(3)) {
        LAS char* scr = (LAS char*)lds + wave * 17408;
        for (int it = gw; it < 544 * 16; it += NGW) lru_item<false>(lp, scr, it >> 4, it & 15, lane);
    }
    SYNC(3);
    if (IN(4)) {
        if (vcu < 8) {
            const int gt = vcu * 512 + tid; const int b = gt >> 10, ch = gt & 1023; const float* ag = AGG + (size_t)(b * 128) * 2048 + ch; float* cr = CARRY + (size_t)(b * 128) * 1024 + ch; float h = 0.f;
#pragma unroll 16
            for (int j = 0; j < 128; ++j) { cr[(size_t)j * 1024] = h; h = ag[(size_t)j * 2048] * h + ag[(size_t)j * 2048 + 1024]; }
            asm volatile("s_waitcnt vmcnt(0)" ::: "memory"); __syncthreads();
            if (tid == 0) { __builtin_amdgcn_fence(__ATOMIC_RELEASE, "agent"); asm volatile("s_waitcnt vmcnt(0)" ::: "memory"); __hip_atomic_fetch_add(barcnt + 32, 1u, __ATOMIC_RELAXED, __HIP_MEMORY_SCOPE_AGENT); }
        }
        { pg8::Gemm g{AO, WbaT, T, 1024, 1024, 1024}; pg8::StaticOrder S; S.init(T, 1024, G, bx); EpiM1 E{GA, TMP};
          pg8::gemm_phase<EpiM1, pg8::StaticOrder, true, true>(lds, g, S, E); }
        while (__builtin_amdgcn_readfirstlane((int)__hip_atomic_load(barcnt + 32, __ATOMIC_RELAXED, __HIP_MEMORY_SCOPE_AGENT)) < (G < 8 ? G : 8)) __builtin_amdgcn_s_sleep(2);
        __builtin_amdgcn_fence(__ATOMIC_ACQUIRE, "agent"); asm volatile("s_waitcnt vmcnt(0)" ::: "memory");
        for (int it = gw; it < 544 * 16; it += NGW) lru_final_light(lp, it >> 4, it & 15, lane);
    }
    SYNC(4);
    if (IN(5)) for (int rep = 0; rep < REPN(5); ++rep) {
        { pg8::Gemm g{BO, WblT, T, 1024, 1024, 1024}; pg8::StaticOrder S; S.init(T, 1024, G, bx); EpiM2 E{GB, TMP, MG};
          pg8::gemm_phase<EpiM2, pg8::StaticOrder, true, true>(lds, g, S, E); }
    }
    SYNC(5);
    if (IN(6)) for (int rep = 0; rep < REPN(6); ++rep) {
        pg8::Gemm g{MG, WoT, T, 1024, 1024, 1024}; pg8::StaticOrder S; S.init(T, 1024, G, bx); EpiO E{a.x_prompt, a.x_sample, H, HB, RSS};
        pg8::gemm_phase<EpiO, pg8::StaticOrder, true, true>(lds, g, S, E);
    }
    SYNC(6);
    if (IN(7)) for (int rep = 0; rep < REPN(7); ++rep) {
        pg8::Gemm g{HB, WupT, T, FF, 1024, 1024}; pg8::StaticOrder S; S.init(T, FF, G, bx); EpiUp E{RSS, UP};
        pg8::gemm_phase<EpiUp, pg8::StaticOrder, true, true>(lds, g, S, E);
    }
    SYNC(7);
    if (IN(8)) {
        { pg8::Gemm g{UP, WdnT, TP, 1024, FF, FF}; pg8::StaticOrder S; S.init(TP, 1024, G, bx); EpiDown E{H};
          pg8::gemm_phase<EpiDown, pg8::StaticOrder, true, true>(lds, g, S, E); }
        { pg8::Gemm g{UP, WdnT, T, 1024, 512, FF}; SplitOrder S{G, bx}; EpiPart E{(float*)S4};
          pg8::gemm_phase<EpiPart, SplitOrder, true, true>(lds, g, S, E); }
    }
    SYNC(8);
    if (IN(9)) {
        f32x4 g[4];
#pragma unroll
        for (int j = 0; j < 4; ++j) g[j] = ((const f32x4*)a.norm_final)[lane + 64 * j];
        for (int m = gw; m < T; m += NGW) {
            f32x4* xr = (f32x4*)(H + (size_t)m * 1024);
            f32x4 v[4]; float s = 0.f;
#pragma unroll
            for (int j = 0; j < 4; ++j) v[j] = xr[lane + 64 * j];
            if (m >= TP) {
                const f32x4* pp = (const f32x4*)((const float*)S4 + (size_t)(m - TP) * 1024) + lane;
#pragma unroll
                for (int kc = 0; kc < 8; ++kc)
#pragma unroll
                    for (int j = 0; j < 4; ++j) v[j] += pp[(size_t)kc * 2048 * 256 + 64 * j];
            }
#pragma unroll
            for (int j = 0; j < 4; ++j) s += (v[j][0] * v[j][0] + v[j][1] * v[j][1]) + (v[j][2] * v[j][2] + v[j][3] * v[j][3]);
            const float rstd = 1.0f / sqrtf(wave_sum(s) * (1.0f / 1024.0f) + EPS);
#pragma unroll
            for (int j = 0; j < 4; ++j) xr[lane + 64 * j] = v[j] * rstd * g[j];
        }
    }
#undef IN
#undef SYNC
}

constexpr int NPH = 10;
#ifndef MK_LAUNCHES
#define MK_LAUNCHES 1
#endif
extern "C" void kernel_launch(void* const* d_in, const int* in_sizes, int n_in, void* d_out, int out_size, void* d_ws, size_t ws_size, hipStream_t stream) {
    static int grid = 0;
    if (grid == 0) {
        if (n_in != 25 || ws_size < WS_END) { fprintf(stderr, "kernel_launch: unexpected n_in %d / ws %zu (need %zu)\n", n_in, ws_size, (size_t)WS_END); grid = -1; return; }
        int dev = 0, cus = 0, per_cu = 0;
        hipGetDevice(&dev); hipDeviceGetAttribute(&cus, hipDeviceAttributeMultiprocessorCount, dev);
        if (hipFuncSetAttribute((const void*)mega, hipFuncAttributeMaxDynamicSharedMemorySize, LDS_BYTES) != hipSuccess) { fprintf(stderr, "hipFuncSetAttribute failed\n"); grid = -1; return; }
        hipOccupancyMaxActiveBlocksPerMultiprocessor(&per_cu, (const void*)mega, 512, LDS_BYTES);
        if (per_cu < 1) { fprintf(stderr, "occupancy query says %d\n", per_cu); per_cu = 1; }
        (void)hipGetLastError();
        grid = cus * 1;
    }
    if (grid < 0) return;
    if (hipMemsetAsync((char*)d_ws + WS_CTL, 0, 256, stream) != hipSuccess) { fprintf(stderr, "memset failed\n"); return; }
    if (hipMemsetAsync((char*)d_ws + WS_XB, 0, 16384, stream) != hipSuccess) { fprintf(stderr, "memset failed\n"); return; }
    Args a{};
    const float** pf = (const float**)&a;
    for (int i = 0; i < 25; ++i) pf[i] = (const float*)d_in[i];
    a.out = (float*)d_out; a.ws = (unsigned char*)d_ws;
#if MK_LAUNCHES == 1
#ifdef PROBE_PREFIX
    { a.ph_lo = 0; a.ph_hi = PROBE_PREFIX; a.flags = PROBE_FLAGS; void* args0[] = {&a};
      if (hipLaunchCooperativeKernel((const void*)mega, dim3(grid), dim3(512), args0, LDS_BYTES, stream) != hipSuccess) fprintf(stderr, "probe launch failed\n");
      if (hipMemsetAsync((char*)d_ws + WS_CTL, 0, 256, stream) != hipSuccess) fprintf(stderr, "memset failed\n"); }
#endif
    a.ph_lo = 0; a.ph_hi = NPH; a.flags = 0;
    void* args[] = {&a};
    hipError_t e = hipLaunchCooperativeKernel((const void*)mega, dim3(grid), dim3(512), args, LDS_BYTES, stream);
    if (e != hipSuccess) fprintf(stderr, "cooperative launch failed: %s (grid %d)\n", hipGetErrorString(e), grid);
#else
    for (int k = 0; k < NPH; ++k) { a.ph_lo = k; a.ph_hi = k + 1; hipLaunchKernelGGL(mega, dim3(grid), dim3(512), LDS_BYTES, stream, a); }
#endif
}
```

```cpp
#include <hip/hip_runtime.h>
#include <hip/hip_cooperative_groups.h>
#include <cstdio>
#include <cstdint>
namespace cg = cooperative_groups;
namespace pg8 {
#define PG8_LAS __attribute__((address_space(3)))
typedef unsigned short bf16_t;
typedef short bf16x8 __attribute__((ext_vector_type(8)));
typedef float f32x4 __attribute__((ext_vector_type(4)));
typedef unsigned u32x4 __attribute__((ext_vector_type(4)));
constexpr int BM = 256, BK = 64, HALF = 128, HTB = HALF * BK * 2  , STAGE_BYTES = 8 * HTB, NXCD = 8, WGM = 8;

__host__ __device__ __forceinline__ int lds_byte(int r, int c) { const int st = (r >> 4) * 2 + (c >> 5), rr = r & 15, cc = c & 31, ob = rr * 64 + cc * 2; return st * 1024 + (ob ^ (((ob >> 9) & 1) << 5)); }
__host__ __device__ __forceinline__ void stage_rc(int b, int& R, int& C) { const int st = b / 1024, sb = b % 1024, swz = sb ^ (((sb >> 9) & 1) << 5); R = (st >> 1) * 16 + swz / 64; C = (st & 1) * 32 + (swz % 64) / 2; }
__host__ __device__ __forceinline__ int perm32(int rho) { const int n = rho >> 4, i = rho & 15; return 8 * (i >> 2) + 4 * n + (i & 3); }

struct Unit { int pm, pn, kc; };
struct Gemm { const bf16_t* A; const bf16_t* Bt; int M, N, K, ld; };

struct StaticOrder {
    int nM, nN, nwg, G, c;
    __host__ __device__ void init(int M, int N, int G_, int c_) { nM = M / BM; nN = N / BM; nwg = nM * nN; G = G_; c = c_; }
    __host__ __device__ bool next(int i, Unit& u) const {
        const long L = (long)i * G + c; if (L >= nwg) return false;
        int wgid = (int)L; { const int q = nwg / NXCD, r = nwg % NXCD, xcd = wgid % NXCD, off = wgid / NXCD; wgid = (xcd < r ? xcd * (q + 1) : r * (q + 1) + (xcd - r) * q) + off; }
        const int nig = WGM * nN, gid = wgid / nig, fm = gid * WGM, gsz = (nM - fm) < WGM ? (nM - fm) : WGM;
        u.pm = fm + ((wgid % nig) % gsz); u.pn = (wgid % nig) / gsz; u.kc = 0; return true;
    }
    __device__ __forceinline__ void a_ready(const Unit&) const {}
    __device__ __forceinline__ void done(const Unit&) const {}
};

template <class Epi, class Sched, bool ALIGN_EPI = false, bool SP2 = false>
__device__ __forceinline__ void gemm_phase(PG8_LAS unsigned char* lds, const Gemm g, const Sched& S, const Epi& E) {
    const int tid = threadIdx.x, wid = __builtin_amdgcn_readfirstlane(tid >> 6), lane = tid & 63, wr = wid >> 2, wc = wid & 3, fr = lane & 15, fq = lane >> 4;
    const int K = g.ld, nt = g.K / BK; const size_t kcb = (size_t)g.K * 2;
    unsigned voffA[2], voffB[2];
#pragma unroll
    for (int i = 0; i < 2; ++i) { int R, C; stage_rc(tid * 16 + i * 8192, R, C); const int Rb = Epi::PERM ? ((R & ~31) + perm32(R & 31)) : R;
        voffA[i] = (unsigned)(R * K + C) * 2u; voffB[i] = (unsigned)(Rb * K + C) * 2u; }
    const size_t kstep = (size_t)(BK * 2);
    const size_t hstep = (size_t)HALF * K * 2;
    const size_t tstep = 2 * hstep;
    const unsigned ldsw = (unsigned)wid * 1024u;
    const int aoff = lds_byte(wr * 64 + fr, fq * 8), boff = lds_byte(wc * 32 + fr, fq * 8);
#define PG8_SA(b, h) (((b) * 2 + (h)) * HTB)
#define PG8_SB(b, h) ((4 + (b) * 2 + (h)) * HTB)
#define PG8_STAGE(bufoff, gbase, voff) do { _Pragma("unroll") for (int _i = 0; _i < 2; ++_i) \
        __builtin_amdgcn_global_load_lds((const unsigned*)((const char*)(gbase) + (voff)[_i]), (PG8_LAS unsigned*)(lds + (bufoff) + ldsw + _i * 8192), 16, 0, 0); } while (0)
#define PG8_LDA(dst, b, h) do { _Pragma("unroll") for (int m = 0; m < 4; ++m) _Pragma("unroll") for (int k = 0; k < 2; ++k) dst[m][k] = *(const PG8_LAS bf16x8*)(lds + PG8_SA(b, h) + aoff + m * 2048 + k * 1024); } while (0)
#define PG8_LDB(dst, b, h) do { _Pragma("unroll") for (int n = 0; n < 2; ++n) _Pragma("unroll") for (int k = 0; k < 2; ++k) dst[n][k] = *(const PG8_LAS bf16x8*)(lds + PG8_SB(b, h) + boff + n * 2048 + k * 1024); } while (0)
#define PG8_MMA(ai, bj, At, Bt) do { __builtin_amdgcn_s_setprio(1); _Pragma("unroll") for (int m = 0; m < 4; ++m) _Pragma("unroll") for (int n = 0; n < 2; ++n) _Pragma("unroll") for (int k = 0; k < 2; ++k) \
        acc[ai][bj][m][n] = __builtin_amdgcn_mfma_f32_16x16x32_bf16(Bt[n][k], At[m][k], acc[ai][bj][m][n], 0, 0, 0); __builtin_amdgcn_s_setprio(0); } while (0)
#define PG8_WAIT_V(n) asm volatile("s_waitcnt vmcnt(" #n ")" ::: "memory")
#define PG8_WAIT_L(n) asm volatile("s_waitcnt lgkmcnt(" #n ")" ::: "memory")
#define PG8_BAR __builtin_amdgcn_s_barrier()
#define PG8_SCHED __builtin_amdgcn_sched_barrier(0)
    Unit cur, nxt; int ui = 0;
    if (!S.next(0, cur)) return;
    f32x4 acc[2][2][4][2];
#pragma unroll
    for (int a = 0; a < 2; ++a)
#pragma unroll
        for (int b = 0; b < 2; ++b)
#pragma unroll
            for (int m = 0; m < 4; ++m)
#pragma unroll
                for (int n = 0; n < 2; ++n) acc[a][b][m][n] = (f32x4){0.f, 0.f, 0.f, 0.f};
    bf16x8 At[4][2], B0[2][2], B1[2][2];
    const char* cA = (const char*)g.A + (size_t)cur.pm * tstep + (size_t)cur.kc * kcb; const char* cB = (const char*)g.Bt + (size_t)cur.pn * tstep + (size_t)cur.kc * kcb;
    S.a_ready(cur);
    if constexpr (SP2) {
        PG8_STAGE(PG8_SB(0, 0), cB, voffB); PG8_STAGE(PG8_SB(0, 1), cB + hstep, voffB); PG8_STAGE(PG8_SA(0, 0), cA, voffA); PG8_STAGE(PG8_SA(0, 1), cA + hstep, voffA);
        if (wr == 1) PG8_BAR;
        PG8_WAIT_V(2); PG8_BAR;
        PG8_STAGE(PG8_SB(1, 0), cB + kstep, voffB); PG8_STAGE(PG8_SA(1, 0), cA + kstep, voffA); PG8_STAGE(PG8_SB(1, 1), cB + hstep + kstep, voffB);
        PG8_WAIT_V(6); PG8_BAR;
    } else {
        PG8_STAGE(PG8_SB(0, 0), cB, voffB); PG8_STAGE(PG8_SA(0, 0), cA, voffA); PG8_STAGE(PG8_SB(0, 1), cB + hstep, voffB); PG8_STAGE(PG8_SA(0, 1), cA + hstep, voffA);
        if (wr == 1) PG8_BAR;
        PG8_WAIT_V(4); PG8_BAR;
        PG8_STAGE(PG8_SB(1, 0), cB + kstep, voffB); PG8_STAGE(PG8_SA(1, 0), cA + kstep, voffA); PG8_STAGE(PG8_SB(1, 1), cB + hstep + kstep, voffB);
        PG8_WAIT_V(6); PG8_BAR;
    }
    for (;;) {
        const bool has_next = S.next(ui + 1, nxt);
        const char* nA = has_next ? (const char*)g.A + (size_t)nxt.pm * tstep + (size_t)nxt.kc * kcb : cA; const char* nB = has_next ? (const char*)g.Bt + (size_t)nxt.pn * tstep + (size_t)nxt.kc * kcb : cB;
        for (int t = 0; t < nt; t += 2) {
            const bool last = (t == nt - 2);
            const char* a1 = cA + (size_t)(t + 1) * kstep;
            const char* a2 = last ? nA : cA + (size_t)(t + 2) * kstep; const char* b2 = last ? nB : cB + (size_t)(t + 2) * kstep;
            const char* a3 = a2 + kstep; const char* b3 = b2 + kstep;
            if (last && has_next) S.a_ready(nxt);
            if constexpr (SP2) {
            PG8_LDB(B0, 0, 0); PG8_LDB(B1, 0, 1); PG8_SCHED; PG8_LDA(At, 0, 0); PG8_STAGE(PG8_SA(1, 1), a1 + hstep, voffA);
            PG8_WAIT_V(8); PG8_WAIT_L(0); PG8_BAR; PG8_MMA(0, 0, At, B0); PG8_MMA(0, 1, At, B1); PG8_BAR; PG8_SCHED;
            PG8_LDA(At, 0, 1); PG8_STAGE(PG8_SB(0, 0), b2, voffB); PG8_STAGE(PG8_SB(0, 1), b2 + hstep, voffB); PG8_STAGE(PG8_SA(0, 0), a2, voffA);
            PG8_WAIT_V(8); PG8_WAIT_L(0); PG8_BAR; PG8_MMA(1, 0, At, B0); PG8_MMA(1, 1, At, B1); PG8_BAR; PG8_SCHED;
            PG8_LDB(B0, 1, 0); PG8_LDB(B1, 1, 1); PG8_SCHED; PG8_LDA(At, 1, 0); PG8_STAGE(PG8_SA(0, 1), a2 + hstep, voffA);
            PG8_WAIT_V(8); PG8_WAIT_L(0); PG8_BAR; PG8_MMA(0, 0, At, B0); PG8_MMA(0, 1, At, B1); PG8_BAR; PG8_SCHED;
            PG8_LDA(At, 1, 1); PG8_STAGE(PG8_SB(1, 0), b3, voffB); PG8_STAGE(PG8_SB(1, 1), b3 + hstep, voffB); PG8_STAGE(PG8_SA(1, 0), a3, voffA);
            PG8_WAIT_V(8); PG8_WAIT_L(0); PG8_BAR; PG8_MMA(1, 0, At, B0); PG8_MMA(1, 1, At, B1); PG8_BAR; PG8_SCHED;
            } else {
            PG8_LDB(B0, 0, 0); PG8_SCHED; PG8_LDA(At, 0, 0); PG8_STAGE(PG8_SA(1, 1), a1 + hstep, voffA);
            PG8_WAIT_L(8); PG8_BAR; PG8_WAIT_L(0); PG8_MMA(0, 0, At, B0); PG8_BAR; PG8_SCHED;
            PG8_LDB(B1, 0, 1); PG8_STAGE(PG8_SB(0, 0), b2, voffB);
            PG8_BAR; PG8_WAIT_L(0); PG8_MMA(0, 1, At, B1); PG8_BAR;
            PG8_LDA(At, 0, 1); PG8_STAGE(PG8_SA(0, 0), a2, voffA);
            PG8_BAR; PG8_WAIT_L(0); PG8_MMA(1, 0, At, B0); PG8_BAR; PG8_SCHED;
            PG8_STAGE(PG8_SB(0, 1), b2 + hstep, voffB);
            PG8_WAIT_V(6); PG8_BAR; PG8_MMA(1, 1, At, B1); PG8_BAR;
            PG8_LDB(B0, 1, 0); PG8_SCHED; PG8_LDA(At, 1, 0); PG8_STAGE(PG8_SA(0, 1), a2 + hstep, voffA);
            PG8_WAIT_L(8); PG8_BAR; PG8_WAIT_L(0); PG8_MMA(0, 0, At, B0); PG8_BAR; PG8_SCHED;
            PG8_LDB(B1, 1, 1); PG8_STAGE(PG8_SB(1, 0), b3, voffB);
            PG8_BAR; PG8_WAIT_L(0); PG8_MMA(0, 1, At, B1); PG8_BAR;
            PG8_LDA(At, 1, 1); PG8_STAGE(PG8_SA(1, 0), a3, voffA);
            PG8_BAR; PG8_WAIT_L(0); PG8_MMA(1, 0, At, B0); PG8_BAR; PG8_SCHED;
            PG8_STAGE(PG8_SB(1, 1), b3 + hstep, voffB);
            PG8_WAIT_V(6); PG8_BAR; PG8_MMA(1, 1, At, B1); PG8_BAR;
            }
        }
        if constexpr (ALIGN_EPI) { if (wr == 0) PG8_BAR; }
        if constexpr (!Epi::AFTER_DRAIN) { E(acc, cur, wr, wc, fr, fq); S.done(cur); }
        if (!has_next) break;
#pragma unroll
        for (int a = 0; a < 2; ++a)
#pragma unroll
            for (int b = 0; b < 2; ++b)
#pragma unroll
                for (int m = 0; m < 4; ++m)
#pragma unroll
                    for (int n = 0; n < 2; ++n) acc[a][b][m][n] = (f32x4){0.f, 0.f, 0.f, 0.f};
        cur = nxt; cA = nA; cB = nB; ++ui;
        if constexpr (ALIGN_EPI) { if (wr == 1) PG8_BAR; }
    }
    PG8_WAIT_V(0);
    if constexpr (!ALIGN_EPI) { if (wr == 0) PG8_BAR; }
    PG8_BAR;
    if constexpr (Epi::AFTER_DRAIN) { E.fused(acc, cur, wr, wc, fr, fq, lds, wid, lane); S.done(cur); }
#undef PG8_SA
#undef PG8_SB
#undef PG8_STAGE
#undef PG8_LDA
#undef PG8_LDB
#undef PG8_MMA
#undef PG8_WAIT_V
#undef PG8_WAIT_L
#undef PG8_BAR
#undef PG8_SCHED
}
}

#define LAS __attribute__((address_space(3)))
typedef unsigned short bf16_t;
typedef short bf16x8 __attribute__((ext_vector_type(8)));
typedef short s16x4 __attribute__((ext_vector_type(4)));
typedef float f32x4 __attribute__((ext_vector_type(4)));
typedef float f32x16 __attribute__((ext_vector_type(16)));
typedef unsigned u32x4 __attribute__((ext_vector_type(4)));
typedef unsigned u32x2 __attribute__((ext_vector_type(2)));
typedef float f32x2_t __attribute__((ext_vector_type(2)));
typedef __bf16 bf16x2_t __attribute__((ext_vector_type(2)));

constexpr int T = 34816, TP = 32768, DM = 1024, NIN = 7168, FF = 4096, SEQP = 8192;
constexpr float EPS = 1e-6f;
constexpr float QSCALE = 0.125f * 1.4426950408889634f;
constexpr size_t O_Y = 0, O_KP = 35651584, O_VP = 69206016, O_CP = 102760448, O_LP = 102772736, O_KS = 102776832, O_VS = 104873984, O_CS = 106971136, O_LS = 107069440;
constexpr size_t SLOT = (size_t)T * 1024 * 2;
constexpr size_t WS_WIN = 0, WS_WBA = 14680064, WS_WBL = WS_WBA + 2097152, WS_WO = WS_WBL + 2097152, WS_WUP = WS_WO + 2097152, WS_WDN = WS_WUP + 8388608,
                 WS_WR = WS_WDN + 8388608, WS_WI = WS_WR + 131072, WS_AGG = WS_WI + 131072, WS_RSS = WS_AGG + 4194304, WS_CTL = WS_RSS + (size_t)34816 * 64, WS_CARRY = WS_CTL + 256, WS_XB = WS_CARRY + 2097152, WS_SLOT0 = 50331648;
static_assert(WS_XB + 16384 <= WS_SLOT0, "ws map");
constexpr size_t WS_END = WS_SLOT0 + 6 * SLOT;
constexpr int LDS_BYTES = 147456;
#ifndef PROBE_FLAGS
#define PROBE_FLAGS 0
#endif
#ifndef REPMASK
#define REPMASK 0
#endif
#define REPN(k) ((((REPMASK) >> (k)) & 1) ? 2 : 1)

struct Args {
    const float *x_prompt, *x_sample, *cache_k, *cache_v, *state_conv, *state_lru, *norm_mix, *norm_mlp, *norm_final, *w_in, *lambda_q, *lambda_k, *head_gain,
        *conv_w, *conv_b, *w_rgate, *b_rgate, *w_igate, *b_igate, *lru_lambda, *w_ba, *w_bl, *w_o, *w_up, *w_down;
    float* out; unsigned char* ws; int ph_lo, ph_hi, flags, pad;
};

__device__ __forceinline__ unsigned pk2(float lo, float hi) { f32x2_t v = {lo, hi}; bf16x2_t b = __builtin_convertvector(v, bf16x2_t); return __builtin_bit_cast(unsigned, b); }
__device__ __forceinline__ bf16_t f2bf(float f) { __bf16 b = (__bf16)f; return __builtin_bit_cast(unsigned short, b); }
__device__ __forceinline__ float bf2f(bf16_t u) { return __uint_as_float(((unsigned)u) << 16); }
__device__ __forceinline__ float bflo(unsigned u) { return __uint_as_float(u << 16); }
__device__ __forceinline__ float bfhi(unsigned u) { return __uint_as_float(u & 0xffff0000u); }
__device__ __forceinline__ float fsigmoid(float x) { return __builtin_amdgcn_rcpf(1.0f + __builtin_amdgcn_exp2f(-1.4426950408889634f * x)); }
__device__ __forceinline__ float gelu_tanh(float x) { const float y = 0.7978845608028654f * (x + 0.044715f * x * x * x); return x * fsigmoid(2.0f * y); }
__device__ __forceinline__ u32x4 pack8(const f32x4& a, const f32x4& b) { u32x4 w; w.x = pk2(a[0], a[1]); w.y = pk2(a[2], a[3]); w.z = pk2(b[0], b[1]); w.w = pk2(b[2], b[3]); return w; }
__device__ __forceinline__ int crow(int r, int hi) { return (r & 3) + 8 * (r >> 2) + 4 * hi; }
#define LDS_FENCE() asm volatile("s_waitcnt lgkmcnt(0)" ::: "memory")
#define MFMA32(a, b, c) __builtin_amdgcn_mfma_f32_32x32x16_bf16((a), (b), (c), 0, 0, 0)

using pg8::Unit;
#define EPI_LOOP(...) _Pragma("unroll") for (int ai = 0; ai < 2; ++ai) _Pragma("unroll") for (int m = 0; m < 4; ++m) { const int row = rbase + ai * 128 + m * 16; \
    _Pragma("unroll") for (int bj = 0; bj < 2; ++bj) { const int col = cbase + bj * 128; const f32x4 v0 = acc[ai][bj][m][0], v1 = acc[ai][bj][m][1]; __VA_ARGS__ } }

struct EpiIn {
    static constexpr bool PERM = true, AFTER_DRAIN = false;
    bf16_t *Q, *Kb, *VT, *XL, *GG, *GA, *GB; float* out;
    __device__ __forceinline__ void operator()(const f32x4 (&acc)[2][2][4][2], const Unit& u, int wr, int wc, int fr, int fq) const {
        const int sec = u.pn >> 2;
        const int cbase = (u.pn & 3) * 256 + wc * 32 + 8 * fq;
        const int rbase = u.pm * 256 + wr * 64 + fr;
        const bool prompt = u.pm < 128;
        if (sec == 0) {
            EPI_LOOP({ *(u32x4*)(Q + (size_t)row * 1024 + col) = pack8(v0 * QSCALE, v1 * QSCALE); })
        } else if (sec == 1) {
            float* ko = prompt ? out + O_KP : out + O_KS - (size_t)TP * 1024;
            EPI_LOOP({ float* o = ko + (size_t)row * 1024 + col; *(f32x4*)o = v0; *(f32x4*)(o + 4) = v1; *(u32x4*)(Kb + (size_t)row * 1024 + col) = pack8(v0, v1); })
        } else if (sec == 2) {
            float* vo = prompt ? out + O_VP : out + O_VS - (size_t)TP * 1024;
            EPI_LOOP({ float* o = vo + (size_t)row * 1024 + col; *(f32x4*)o = v0; *(f32x4*)(o + 4) = v1; *(u32x4*)(VT + (size_t)row * 1024 + col) = pack8(v0, v1); })
        } else if (sec == 3) {
            EPI_LOOP({ *(u32x4*)(XL + (size_t)row * 1024 + col) = pack8(v0, v1);
                if (prompt) { const int pos = row & (SEQP - 1); if (pos >= SEQP - 3) { float* o = out + O_CP + (size_t)((row >> 13) * 3 + pos - (SEQP - 3)) * 1024 + col; *(f32x4*)o = v0; *(f32x4*)(o + 4) = v1; } }
                else { const int rs = row - TP; const int pos = rs & 63; if (pos >= 61) { float* o = out + O_CS + (size_t)((rs >> 6) * 3 + pos - 61) * 1024 + col; *(f32x4*)o = v0; *(f32x4*)(o + 4) = v1; } } })
        } else if (sec == 4) {
            EPI_LOOP({ f32x4 a, b; _Pragma("unroll") for (int j = 0; j < 4; ++j) { a[j] = gelu_tanh(v0[j]); b[j] = gelu_tanh(v1[j]); }
                *(u32x4*)(GG + (size_t)row * 1024 + col) = pack8(a, b); })
        } else {
            bf16_t* G = (sec == 5) ? GA : GB;
            EPI_LOOP({ f32x4 a, b; _Pragma("unroll") for (int j = 0; j < 4; ++j) { a[j] = fsigmoid(v0[j]); b[j] = fsigmoid(v1[j]); }
                *(u32x4*)(G + (size_t)row * 1024 + col) = pack8(a, b); })
        }
    }
};
__device__ __forceinline__ void unpack8(const u32x4 w, f32x4& a, f32x4& b) { a[0] = bflo(w.x); a[1] = bfhi(w.x); a[2] = bflo(w.y); a[3] = bfhi(w.y); b[0] = bflo(w.z); b[1] = bfhi(w.z); b[2] = bflo(w.w); b[3] = bfhi(w.w); }
struct EpiM1 {
    static constexpr bool PERM = true, AFTER_DRAIN = false;
    const bf16_t* G; bf16_t* O;
    __device__ __forceinline__ void operator()(const f32x4 (&acc)[2][2][4][2], const Unit& u, int wr, int wc, int fr, int fq) const {
        const int cbase = u.pn * 256 + wc * 32 + 8 * fq, rbase = u.pm * 256 + wr * 64 + fr;
        EPI_LOOP({ f32x4 g0, g1; unpack8(*(const u32x4*)(G + (size_t)row * 1024 + col), g0, g1); *(u32x4*)(O + (size_t)row * 1024 + col) = pack8(g0 * v0, g1 * v1); })
    }
};
struct EpiM2 {
    static constexpr bool PERM = true, AFTER_DRAIN = false;
    const bf16_t* G; const bf16_t* Tm; bf16_t* O;
    __device__ __forceinline__ void operator()(const f32x4 (&acc)[2][2][4][2], const Unit& u, int wr, int wc, int fr, int fq) const {
        const int cbase = u.pn * 256 + wc * 32 + 8 * fq, rbase = u.pm * 256 + wr * 64 + fr;
        EPI_LOOP({ f32x4 g0, g1, t0, t1; unpack8(*(const u32x4*)(G + (size_t)row * 1024 + col), g0, g1); unpack8(*(const u32x4*)(Tm + (size_t)row * 1024 + col), t0, t1);
            *(u32x4*)(O + (size_t)row * 1024 + col) = pack8(t0 + g0 * v0, t1 + g1 * v1); })
    }
};
struct EpiO {
    static constexpr bool PERM = true, AFTER_DRAIN = false;
    const float *xp, *xs; float* H; bf16_t* HB; float* RSS;
    __device__ __forceinline__ void operator()(const f32x4 (&acc)[2][2][4][2], const Unit& u, int wr, int wc, int fr, int fq) const {
        const int cbase = u.pn * 256 + wc * 32 + 8 * fq, rbase = u.pm * 256 + wr * 64 + fr;
        const float* xb = (u.pm < 128) ? xp : xs - (size_t)TP * 1024;
#pragma unroll
        for (int ai = 0; ai < 2; ++ai)
#pragma unroll
            for (int m = 0; m < 4; ++m) { const int row = rbase + ai * 128 + m * 16; float ss = 0.f;
#pragma unroll
                for (int bj = 0; bj < 2; ++bj) { const int col = cbase + bj * 128; const float* xr = xb + (size_t)row * 1024 + col;
                    const f32x4 h0 = *(const f32x4*)xr + acc[ai][bj][m][0], h1 = *(const f32x4*)(xr + 4) + acc[ai][bj][m][1];
                    float* o = H + (size_t)row * 1024 + col; *(f32x4*)o = h0; *(f32x4*)(o + 4) = h1;
                    *(u32x4*)(HB + (size_t)row * 1024 + col) = pack8(h0, h1);
                    ss += (h0[0] * h0[0] + h0[1] * h0[1]) + (h0[2] * h0[2] + h0[3] * h0[3]) + (h1[0] * h1[0] + h1[1] * h1[1]) + (h1[2] * h1[2] + h1[3] * h1[3]); }
                ss += __shfl_xor(ss, 16); ss += __shfl_xor(ss, 32);
                if (fq == 0) RSS[(size_t)row * 16 + u.pn * 4 + wc] = ss; }
    }
};
struct EpiUp {
    static constexpr bool PERM = true, AFTER_DRAIN = false;
    const float* RSS; bf16_t* UP;
    __device__ __forceinline__ void operator()(const f32x4 (&acc)[2][2][4][2], const Unit& u, int wr, int wc, int fr, int fq) const {
        const int cbase = u.pn * 256 + wc * 32 + 8 * fq, rbase = u.pm * 256 + wr * 64 + fr;
#pragma unroll
        for (int ai = 0; ai < 2; ++ai)
#pragma unroll
            for (int m = 0; m < 4; ++m) { const int row = rbase + ai * 128 + m * 16;
                const f32x4* rp = (const f32x4*)(RSS + (size_t)row * 16); const f32x4 s = (rp[0] + rp[1]) + (rp[2] + rp[3]);
                const float rstd = __builtin_amdgcn_rsqf(((s[0] + s[1]) + (s[2] + s[3])) * (1.0f / 1024.0f) + EPS);
#pragma unroll
                for (int bj = 0; bj < 2; ++bj) { const int col = cbase + bj * 128; f32x4 a = acc[ai][bj][m][0] * rstd, b = acc[ai][bj][m][1] * rstd;
#pragma unroll
                    for (int j = 0; j < 4; ++j) { a[j] = fmaxf(a[j], 0.f); a[j] *= a[j]; b[j] = fmaxf(b[j], 0.f); b[j] *= b[j]; }
                    *(u32x4*)(UP + (size_t)row * FF + col) = pack8(a, b); } }
    }
};
struct EpiDown {
    static constexpr bool PERM = true, AFTER_DRAIN = false;
    float* H;
    __device__ __forceinline__ void operator()(const f32x4 (&acc)[2][2][4][2], const Unit& u, int wr, int wc, int fr, int fq) const {
        const int cbase = u.pn * 256 + wc * 32 + 8 * fq, rbase = u.pm * 256 + wr * 64 + fr;
        EPI_LOOP({ float* o = H + (size_t)row * 1024 + col; const f32x4 h0 = *(const f32x4*)o + v0, h1 = *(const f32x4*)(o + 4) + v1; *(f32x4*)o = h0; *(f32x4*)(o + 4) = h1; })
    }
};

struct EpiPart {
    static constexpr bool PERM = true, AFTER_DRAIN = false;
    float* PART;
    __device__ __forceinline__ void operator()(const f32x4 (&acc)[2][2][4][2], const Unit& u, int wr, int wc, int fr, int fq) const {
        const int cbase = u.pn * 256 + wc * 32 + 8 * fq, rbase = u.pm * 256 + wr * 64 + fr;
        float* pb = PART + (size_t)u.kc * 2048 * 1024;
        EPI_LOOP({ float* o = pb + (size_t)(row - TP) * 1024 + col; *(f32x4*)o = v0; *(f32x4*)(o + 4) = v1; })
    }
};
struct SplitOrder {
    int G, c;
    __device__ __forceinline__ bool next(int i, Unit& u) const { const int L = i * G + c; if (L >= 256) return false; u.pm = 128 + (L >> 5); const int r = L & 31; u.pn = r >> 3; u.kc = r & 7; return true; }
    __device__ __forceinline__ void a_ready(const Unit&) const {}
    __device__ __forceinline__ void done(const Unit&) const {}
};
__device__ __forceinline__ float wave_sum(float v) {
#pragma unroll
    for (int o = 1; o < 64; o <<= 1) v += __shfl_xor(v, o);
    return v;
}
__device__ __forceinline__ void transpose_item(const float* __restrict__ W, int K, int N, const float* __restrict__ kscale, bf16_t* WT, LAS float* scr, int item, int lane) {
    const int nblk = N / 32, kb = item / nblk, nb = item % nblk, k0 = 64 * kb, n0 = 32 * nb;
#pragma unroll 8
    for (int i = 0; i < 32; ++i) { const int kk = 2 * i + (lane >> 5); float v = W[(size_t)(k0 + kk) * N + n0 + (lane & 31)]; if (kscale) v *= kscale[k0 + kk]; scr[kk * 33 + (lane & 31)] = v; }
    LDS_FENCE();
    const int c = lane & 7;
#pragma unroll
    for (int j = 0; j < 4; ++j) { const int n = (lane >> 3) + 8 * j; const LAS float* s = scr + (8 * c) * 33 + n;
        u32x4 o; o.x = pk2(s[0 * 33], s[1 * 33]); o.y = pk2(s[2 * 33], s[3 * 33]); o.z = pk2(s[4 * 33], s[5 * 33]); o.w = pk2(s[6 * 33], s[7 * 33]);
        *(u32x4*)(WT + (size_t)(n0 + n) * K + k0 + 8 * c) = o; }
    LDS_FENCE();
}

struct LruP { const bf16_t *XL, *GG, *WRt, *WIt; bf16_t* BO; bf16_t *LA, *U; float* AGG; const float* CARRY; const float *conv_w, *conv_b, *b_r, *b_i, *lam, *state_conv, *state_lru; float* out; };
template <bool FINAL>
__device__ __forceinline__ void lru_item(const LruP& p, LAS char* scr, int tl, int n, int lane) {
    const int l31 = lane & 31, hi = lane >> 5;
    const bool samp = tl >= 512; const int bs = tl - 512, c = tl & 127, bp = tl >> 7;
    const size_t tok0 = (size_t)tl * 64;
    LAS bf16_t* sx = (LAS bf16_t*)scr;
    const unsigned lvoff = (unsigned)((4 * hi * 1024 + l31) * 2);
    {
        const int ch = n * 64 + lane;
        const float w0 = p.conv_w[ch], w1 = p.conv_w[1024 + ch], w2 = p.conv_w[2048 + ch], w3 = p.conv_w[3072 + ch], cb = p.conv_b[ch];
        float x0, x1, x2;
        if (samp) { x0 = p.state_conv[(size_t)(bs * 3 + 0) * 1024 + ch]; x1 = p.state_conv[(size_t)(bs * 3 + 1) * 1024 + ch]; x2 = p.state_conv[(size_t)(bs * 3 + 2) * 1024 + ch]; }
        else if (c == 0) { x0 = 0.f; x1 = 0.f; x2 = 0.f; }
        else { x0 = bf2f(p.XL[(tok0 - 3) * 1024 + ch]); x1 = bf2f(p.XL[(tok0 - 2) * 1024 + ch]); x2 = bf2f(p.XL[(tok0 - 1) * 1024 + ch]); }
        LAS char* raw = scr + 9216;
        { const char* gx = (const char*)(p.XL + tok0 * 1024 + n * 64); const unsigned go = (unsigned)((lane >> 3) * 2048 + (lane & 7) * 16);
          u32x4 v[8];
#pragma unroll
          for (int i = 0; i < 8; ++i) v[i] = *(const u32x4*)(gx + (size_t)i * 8 * 2048 + go);
#pragma unroll
          for (int i = 0; i < 8; ++i) *(LAS u32x4*)(raw + ((lane >> 3) + 8 * i) * 128 + (lane & 7) * 16) = v[i]; }
        LDS_FENCE();
#pragma unroll 16
        for (int t = 0; t < 64; ++t) { const float x3 = bf2f(*(const LAS bf16_t*)(raw + t * 128 + lane * 2)); const float xc = cb + w0 * x0 + w1 * x1 + w2 * x2 + w3 * x3; sx[t * 72 + lane] = f2bf(xc); x0 = x1; x1 = x2; x2 = x3; }
    }
    LDS_FENCE();
    for (int nt = 0; nt < 2; ++nt) {
        const int chd = n * 64 + 32 * nt + l31;
        f32x16 R[2], I[2];
#pragma unroll
        for (int r = 0; r < 16; ++r) { R[0][r] = 0.f; R[1][r] = 0.f; I[0][r] = 0.f; I[1][r] = 0.f; }
#pragma unroll
        for (int kk = 0; kk < 4; ++kk) {
            const bf16x8 br = *(const bf16x8*)(p.WRt + (size_t)chd * 64 + 16 * kk + 8 * hi);
            const bf16x8 bi = *(const bf16x8*)(p.WIt + (size_t)chd * 64 + 16 * kk + 8 * hi);
#pragma unroll
            for (int mt = 0; mt < 2; ++mt) { const bf16x8 a = *(const LAS bf16x8*)(scr + (32 * mt + l31) * 144 + (16 * kk + 8 * hi) * 2); R[mt] = MFMA32(a, br, R[mt]); I[mt] = MFMA32(a, bi, I[mt]); }
        }
        const float brv = p.b_r[chd], biv = p.b_i[chd];
        const float sp8 = -8.0f * log1pf(__expf(-p.lam[chd]));
#pragma unroll
        for (int mt = 0; mt < 2; ++mt)
#pragma unroll
            for (int r = 0; r < 16; ++r) { const int t = 32 * mt + crow(r, hi); const float xcv = bf2f(sx[t * 72 + 32 * nt + l31]);
                const float rg = fsigmoid(R[mt][r] + brv), ig = fsigmoid(I[mt][r] + biv);
                const bf16_t lab = f2bf(rg * sp8); const float la = bf2f(lab), av = __builtin_amdgcn_exp2f(la * 1.4426950408889634f), x2 = 2.0f * la;
                const float ser = -x2 * (1.0f + x2 * (0.5f + x2 * (0.16666667f + x2 * (0.041666668f + x2 * 0.008333334f))));
                const float om = (x2 > -0.25f) ? ser : (1.0f - av * av);
                const bf16_t ub16 = f2bf(__builtin_amdgcn_sqrtf(om) * ig * xcv);
                R[mt][r] = av; I[mt][r] = bf2f(ub16);
                if (!FINAL) { const size_t ub = ((tok0 + 32 * mt + (r & 3) + 8 * (r >> 2)) * 1024 + n * 64 + 32 * nt) * 2;
                    *(bf16_t*)((char*)p.LA + ub + lvoff) = lab; *(bf16_t*)((char*)p.U + ub + lvoff) = ub16; } }
        float oA[8], oH[8], pA[8], pH[8];
#pragma unroll
        for (int gi = 0; gi < 8; ++gi) { float A = 1.f, H = 0.f;
#pragma unroll
            for (int j = 0; j < 4; ++j) { const float a = R[gi >> 2][(gi & 3) * 4 + j]; H = a * H + I[gi >> 2][(gi & 3) * 4 + j]; A *= a; }
            oA[gi] = A; oH[gi] = H; pA[gi] = __shfl_xor(A, 32); pH[gi] = __shfl_xor(H, 32); }
        float h = 0.f;
        if (FINAL) {
            if (samp) h = p.state_lru[(size_t)bs * 1024 + chd];
            else h = p.CARRY[(size_t)tl * 1024 + chd];
        }
        float cin[8], Atot = 1.f;
#pragma unroll
        for (int k = 0; k < 8; ++k) { const float Alo = hi ? pA[k] : oA[k], Hlo = hi ? pH[k] : oH[k], Ahi = hi ? oA[k] : pA[k], Hhi = hi ? oH[k] : pH[k];
            const float hm = Alo * h + Hlo; cin[k] = hi ? hm : h; h = Ahi * hm + Hhi; Atot *= Alo * Ahi; }
        if (!FINAL) { if (hi == 0 && !samp) { p.AGG[(size_t)tl * 2048 + chd] = Atot; p.AGG[(size_t)tl * 2048 + 1024 + chd] = h; } }
        else {
#pragma unroll
            for (int gi = 0; gi < 8; ++gi) { float hh = cin[gi];
#pragma unroll
                for (int j = 0; j < 4; ++j) { const int r = (gi & 3) * 4 + j, mt = gi >> 2; hh = R[mt][r] * hh + I[mt][r]; const size_t ub = ((tok0 + 32 * mt + (r & 3) + 8 * (r >> 2)) * 1024 + n * 64 + 32 * nt) * 2;
                    *(bf16_t*)((char*)p.BO + ub + lvoff) = f2bf(hh * bf2f(*(const bf16_t*)((const char*)p.GG + ub + lvoff))); } }
            if (hi == 0) { if (samp) p.out[O_LS + (size_t)bs * 1024 + chd] = h; else if (c == 127) p.out[O_LP + (size_t)bp * 1024 + chd] = h; }
        }
    }
    LDS_FENCE();
}

__device__ __forceinline__ void lru_final_light(const LruP& p, int tl, int n, int lane) {
    const bool samp = tl >= 512; const int bs = tl - 512, c = tl & 127, bp = tl >> 7; const size_t tok0 = (size_t)tl * 64;
    const int ch = n * 64 + lane; const unsigned l2 = (unsigned)lane * 2u;
    float h = samp ? p.state_lru[(size_t)bs * 1024 + ch] : p.CARRY[(size_t)tl * 1024 + ch];
#pragma unroll 16
    for (int t = 0; t < 64; ++t) { const size_t ub = ((tok0 + t) * 1024 + n * 64) * 2;
        const float la = bf2f(*(const bf16_t*)((const char*)p.LA + ub + l2)), u = bf2f(*(const bf16_t*)((const char*)p.U + ub + l2)), gg = bf2f(*(const bf16_t*)((const char*)p.GG + ub + l2));
        h = __builtin_amdgcn_exp2f(la * 1.4426950408889634f) * h + u;
        *(bf16_t*)((char*)p.BO + ub + l2) = f2bf(h * gg); }
    if (samp) p.out[O_LS + (size_t)bs * 1024 + ch] = h; else if (c == 127) p.out[O_LP + (size_t)bp * 1024 + ch] = h;
}
constexpr int AT_KB = 16384, AT_BUF = 32768, AT_EXCH = 2 * AT_BUF, AT_WSF = AT_EXCH + 65536;
static_assert(AT_WSF + 2048 <= LDS_BYTES, "attention LDS map");
typedef short v4i16_t __attribute__((ext_vector_type(4)));
struct AttP { const bf16_t *Q, *Kb, *VT; bf16_t* AO; const float *cache_k, *cache_v, *head_gain; int flags; };
template <bool SAMPLE>
__device__ __forceinline__ void attn_unit(const AttP& p, LAS char* lds, int b, int h, int qb, float lam) {
    const int tid = threadIdx.x, lane = tid & 63, l31 = lane & 31, hi = lane >> 5;
    const int w = __builtin_amdgcn_readfirstlane(tid >> 6), c = w >> 2, wq = w & 3;
    const size_t tok0 = SAMPLE ? (size_t)(TP + b * 64) : (size_t)b * SEQP;
    const int q0 = SAMPLE ? 0 : qb * 128;
    const int NT = SAMPLE ? 17 : 2 * qb + 2;
    const bool active = SAMPLE ? (wq < 2) : true;
    const int myNT = SAMPLE ? 17 : (wq < 2 ? NT - 1 : NT);
    LAS float* wsf = (LAS float*)(lds + AT_WSF) + w * 64;
    const int kfo = l31 * 256, kfx = (c * 8 + hi) ^ (l31 & 15);
    const int vq = (lane & 15) >> 2, vfo = (4 * hi + vq) * 256 + ((lane >> 4) & 1) * 32 + (lane & 3) * 8;
    const unsigned aovoff = (unsigned)((4 * hi * 1024 + l31) * 2);
    bf16x8 qf[4];
    { const bf16_t* qp = p.Q + (tok0 + q0 + (active ? wq : 0) * 32 + l31) * 1024 + h * 128 + c * 64 + hi * 8;
#pragma unroll
      for (int d0 = 0; d0 < 4; ++d0) qf[d0] = *(const bf16x8*)(qp + d0 * 16); }
    f32x16 O[4];
#pragma unroll
    for (int dt = 0; dt < 4; ++dt)
#pragma unroll
        for (int r = 0; r < 16; ++r) O[dt][r] = 0.f;
    float mrun = 0.f, lrun = 0.f;
    u32x4 st[4];
    if (!SAMPLE) { st[0] = st[1] = st[2] = st[3] = (u32x4){0u, 0u, 0u, 0u}; }
    const unsigned coff_l = (unsigned)(((tid >> 5) * 1024 + (tid & 31) * 4) * 4);
    unsigned ksrc[2], vsrc[2];
#pragma unroll
    for (int i = 0; i < 2; ++i) { const int row = 4 * (w * 2 + i) + (lane >> 4), chp = lane & 15;
        ksrc[i] = (unsigned)((row * 1024 + (chp ^ (row & 15)) * 8) * 2); vsrc[i] = (unsigned)((row * 1024 + (chp ^ ((row & 3) << 2)) * 8) * 2); }
#define DMA_K(trow_, buf_) do { const char* gk_ = (const char*)(p.Kb + (size_t)(trow_) * 1024 + h * 128); _Pragma("unroll") for (int i = 0; i < 2; ++i) \
            __builtin_amdgcn_global_load_lds((const unsigned*)(gk_ + ksrc[i]), (LAS unsigned*)(lds + (buf_) * AT_BUF + (w * 2 + i) * 1024), 16, 0, 0); } while (0)
#define DMA_V(trow_, buf_) do { const char* gv_ = (const char*)(p.VT + (size_t)(trow_) * 1024 + h * 128); _Pragma("unroll") for (int i = 0; i < 2; ++i) \
            __builtin_amdgcn_global_load_lds((const unsigned*)(gv_ + vsrc[i]), (LAS unsigned*)(lds + (buf_) * AT_BUF + AT_KB + (w * 2 + i) * 1024), 16, 0, 0); } while (0)
#define LOAD_F32(src_, t_) do { _Pragma("unroll") for (int i = 0; i < 4; ++i) { \
            st[i] = *(const u32x4*)((const char*)((src_) + (((size_t)b * 1024 + (t_) * 64 + 16 * i) * 8 + h) * 128) + coff_l); } } while (0)
#define STORE_F32(buf_, boff_, isv_) do { LAS char* kb_ = lds + (buf_) * AT_BUF + (boff_); _Pragma("unroll") for (int i = 0; i < 4; ++i) { const int id = tid + 512 * i; const int row = id >> 5, c4 = id & 31; \
            u32x2 kk; kk.x = pk2(__uint_as_float(st[i][0]), __uint_as_float(st[i][1])); kk.y = pk2(__uint_as_float(st[i][2]), __uint_as_float(st[i][3])); \
            const int sw_ = (isv_) ? ((row & 3) << 2) : (row & 15); \
            *(LAS u32x2*)(kb_ + row * 256 + (((c4 >> 1) ^ sw_) << 4) + (c4 & 1) * 8) = kk; } } while (0)
    if (SAMPLE) { LOAD_F32(p.cache_k, 0); STORE_F32(0, 0, 0); } else { DMA_K(tok0, 0); }
    __syncthreads();
    mrun = 0.f;
    bf16x8 pa0, pa1, pa2, pa3;
    pa0 = pa1 = pa2 = pa3 = (bf16x8){0, 0, 0, 0, 0, 0, 0, 0};
#define VLOAD(dst_, s_) do { _Pragma("unroll") for (int dt = 0; dt < 4; ++dt) { LAS char* vp = vb + vfo + ((dt ^ vq) << 6) + (16 * (s_)) * 256; \
                    const v4i16_t lo_ = __builtin_amdgcn_ds_read_tr16_b64_v4i16((LAS v4i16_t*)vp), hh_ = __builtin_amdgcn_ds_read_tr16_b64_v4i16((LAS v4i16_t*)(vp + 8 * 256)); \
                    dst_[dt] = __builtin_shufflevector(lo_, hh_, 0, 1, 2, 3, 4, 5, 6, 7); } } while (0)
#define PKP(P_, q_) __builtin_bit_cast(bf16x8, (u32x4){pk2(P_[8 * q_ + 0], P_[8 * q_ + 1]), pk2(P_[8 * q_ + 2], P_[8 * q_ + 3]), pk2(P_[8 * q_ + 4], P_[8 * q_ + 5]), pk2(P_[8 * q_ + 6], P_[8 * q_ + 7])})
#define PVMM(pa_, vf_) do { _Pragma("unroll") for (int dt = 0; dt < 4; ++dt) O[dt] = MFMA32(pa_, vf_[dt], O[dt]); } while (0)
#define PV_ALL() do { bf16x8 va[4]; VLOAD(va, 0); PVMM(pa0, va); VLOAD(va, 1); PVMM(pa1, va); VLOAD(va, 2); PVMM(pa2, va); VLOAD(va, 3); PVMM(pa3, va); } while (0)
#define QK_MAX(t_, kb_) \
            const bool maskt = !SAMPLE && ((t_) >= myNT);        \
            f32x16 p0, p1; \
            _Pragma("unroll") for (int r = 0; r < 16; ++r) { p0[r] = 0.f; p1[r] = 0.f; } \
            _Pragma("unroll") for (int d0 = 0; d0 < 4; ++d0) { \
                const bf16x8 k0 = *(const LAS bf16x8*)((kb_) + kfo + ((kfx ^ (d0 << 1)) << 4)); \
                const bf16x8 k1 = *(const LAS bf16x8*)((kb_) + kfo + 8192 + ((kfx ^ (d0 << 1)) << 4)); \
                p0 = MFMA32(k0, qf[d0], p0); p1 = MFMA32(k1, qf[d0], p1); } \
            __builtin_amdgcn_sched_group_barrier(0x100, 4, 0); \
            _Pragma("unroll") for (int i_ = 0; i_ < 2; ++i_) { __builtin_amdgcn_sched_group_barrier(0x008, 1, 0); __builtin_amdgcn_sched_group_barrier(0x100, 2, 0); } \
            __builtin_amdgcn_sched_group_barrier(0x008, 6, 0); \
            float rm = fmaxf(fmaxf(p0[0], p1[0]), p0[1]); \
            _Pragma("unroll") for (int r = 2; r < 16; r += 2) rm = fmaxf(fmaxf(rm, p0[r]), p0[r + 1]); \
            _Pragma("unroll") for (int r = 1; r < 16; r += 2) rm = fmaxf(fmaxf(rm, p1[r]), p1[(r + 1) & 15]); \
            rm = fmaxf(rm, __shfl_xor(rm, 32)) - mrun; \
            if (maskt) rm = 0.f; \
            const bool resc = __any(rm > 8.0f) || (t_) == 0;     \
            float alpha = 1.0f; \
            if (resc) { const float dl = (rm > 8.0f || (t_) == 0) ? rm : 0.f; alpha = __builtin_amdgcn_exp2f(-dl); mrun += dl; lrun *= alpha; } \
            const float sh = maskt ? 1e30f : mrun; \
            _Pragma("unroll") for (int r = 0; r < 16; ++r) { p0[r] -= sh; p1[r] -= sh; } \
            __builtin_amdgcn_sched_barrier(0);
#define O_RESCALE() do { if (resc) { if (hi == 0) wsf[l31] = alpha; LDS_FENCE(); \
                _Pragma("unroll") for (int r = 0; r < 16; ++r) { const float a_ = wsf[crow(r, hi)]; _Pragma("unroll") for (int dt = 0; dt < 4; ++dt) O[dt][r] *= a_; } LDS_FENCE(); } } while (0)
    if (!SAMPLE) { DMA_K(tok0 + 64, 1); DMA_V(tok0, 0); }
    if (active) {
        QK_MAX(0, lds)
        float ls = 0.f;
#pragma unroll
        for (int r = 0; r < 16; ++r) { p0[r] = __builtin_amdgcn_exp2f(p0[r]); p1[r] = __builtin_amdgcn_exp2f(p1[r]); ls += p0[r] + p1[r]; }
        lrun += ls;
        pa0 = PKP(p0, 0); pa1 = PKP(p0, 1); pa2 = PKP(p1, 0); pa3 = PKP(p1, 1);
    }
    if (SAMPLE) { LOAD_F32(p.cache_k, 1); STORE_F32(1, 0, 0); LOAD_F32(p.cache_v, 0); STORE_F32(0, AT_KB, 1); }
    __syncthreads();
    for (int t = 1; t < NT; ++t) {
        const int buf = t & 1;
        if (!SAMPLE) { if (t + 1 < NT) DMA_K(tok0 + (size_t)(t + 1) * 64, buf ^ 1); DMA_V(tok0 + (size_t)t * 64, buf); }
        else { if (t + 1 == 16) DMA_K(tok0, buf ^ 1); if (t == 16) DMA_V(tok0, buf); }
        LAS char* vb = lds + (buf ^ 1) * AT_BUF + AT_KB;
        if (active) {
            QK_MAX(t, lds + buf * AT_BUF)
            float ls = 0.f;
            bf16x8 va[4];
#define EXP8(P_, q_) do { _Pragma("unroll") for (int r = 8 * (q_); r < 8 * (q_) + 8; ++r) { P_[r] = __builtin_amdgcn_exp2f(P_[r]); ls += P_[r]; } } while (0)
            VLOAD(va, 0); EXP8(p0, 0); PVMM(pa0, va); pa0 = PKP(p0, 0);
            VLOAD(va, 1); EXP8(p0, 1); PVMM(pa1, va); pa1 = PKP(p0, 1);
            VLOAD(va, 2); EXP8(p1, 0); PVMM(pa2, va); pa2 = PKP(p1, 0);
            VLOAD(va, 3); EXP8(p1, 1); PVMM(pa3, va); pa3 = PKP(p1, 1);
#undef EXP8
            __builtin_amdgcn_sched_group_barrier(0x100, 8, 0); __builtin_amdgcn_sched_group_barrier(0x002, 8, 0);
#pragma unroll
            for (int i_ = 0; i_ < 8; ++i_) { __builtin_amdgcn_sched_group_barrier(0x008, 1, 0); __builtin_amdgcn_sched_group_barrier(0x100, 2, 0); __builtin_amdgcn_sched_group_barrier(0x002, 5, 0); }
#pragma unroll
            for (int i_ = 0; i_ < 4; ++i_) { __builtin_amdgcn_sched_group_barrier(0x008, 1, 0); __builtin_amdgcn_sched_group_barrier(0x100, 2, 0); __builtin_amdgcn_sched_group_barrier(0x002, 4, 0); }
#pragma unroll
            for (int i_ = 0; i_ < 4; ++i_) { __builtin_amdgcn_sched_group_barrier(0x008, 1, 0); __builtin_amdgcn_sched_group_barrier(0x002, 4, 0); }
            lrun += ls;
            O_RESCALE();
        }
        if (SAMPLE) { if (t + 1 < 16) { LOAD_F32(p.cache_k, t + 1); STORE_F32(buf ^ 1, 0, 0); } if (t < 16) { LOAD_F32(p.cache_v, t); STORE_F32(buf, AT_KB, 1); } }
        __syncthreads();
    }
    if (active) { LAS char* vb = lds + ((NT - 1) & 1) * AT_BUF + AT_KB; PV_ALL(); }
    __syncthreads();
#undef QK_MAX
#undef O_RESCALE
#undef VLOAD
#undef PKP
#undef PVMM
#undef PV_ALL
    if (active) {
        const float lt = lrun + __shfl_xor(lrun, 32);
        const float sc = (c == 0 ? 1.0f : lam) * __builtin_amdgcn_rcpf(lt);
        if (hi == 0) wsf[l31] = sc;
        LDS_FENCE();
#pragma unroll
        for (int r = 0; r < 16; ++r) { const float a = wsf[crow(r, hi)];
#pragma unroll
            for (int dt = 0; dt < 4; ++dt) O[dt][r] *= a; }
        LDS_FENCE();
    }
    LAS float* ex = (LAS float*)(lds + AT_EXCH) + wq * 4096;
    if (active && c == 1) {
#pragma unroll
        for (int dt = 0; dt < 4; ++dt)
#pragma unroll
            for (int r = 0; r < 16; ++r) ex[(dt * 16 + r) * 64 + lane] = O[dt][r];
    }
    __syncthreads();
    if (active && c == 0) {
        float hg[4];
#pragma unroll
        for (int dt = 0; dt < 4; ++dt) hg[dt] = p.head_gain[32 * dt + l31] * 0.8f;
#pragma unroll
        for (int r = 0; r < 16; ++r) {
            float o[4], ss = 0.f;
#pragma unroll
            for (int dt = 0; dt < 4; ++dt) { o[dt] = O[dt][r] - ex[(dt * 16 + r) * 64 + lane]; ss += o[dt] * o[dt]; }
            ss += __shfl_xor(ss, 1); ss += __shfl_xor(ss, 2); ss += __shfl_xor(ss, 4); ss += __shfl_xor(ss, 8); ss += __shfl_xor(ss, 16);
            const float rs = __builtin_amdgcn_rsqf(ss * (1.0f / 128.0f) + EPS);
            char* op = (char*)(p.AO + (tok0 + q0 + wq * 32 + (r & 3) + 8 * (r >> 2)) * 1024 + h * 128);
#pragma unroll
            for (int dt = 0; dt < 4; ++dt) *(bf16_t*)(op + 64 * dt + aovoff) = f2bf(o[dt] * rs * hg[dt]);
        }
    }
    __syncthreads();
}

#define XB_TMO      128
#define XB_XCNT(j)  (256  + 64 * (j))
#define XB_XSUB(j)  (1280 + 64 * (j))
#define XB_XGEN(j)  (2304 + 64 * (j))
#define XB_TOP      3328
#define XB_TOPGEN   3392
#define XCD_BAR_WORDS 3456
#define XB_SPIN_CAP (1u << 18)

__device__ __forceinline__ unsigned xb_ld(unsigned* p)              { return __hip_atomic_load(p, __ATOMIC_RELAXED, __HIP_MEMORY_SCOPE_AGENT); }
__device__ __forceinline__ unsigned xb_add(unsigned* p, unsigned v) { return __hip_atomic_fetch_add(p, v, __ATOMIC_RELAXED, __HIP_MEMORY_SCOPE_AGENT); }
__device__ __forceinline__ unsigned xb_xcc_id() { return (unsigned)__builtin_amdgcn_s_getreg((3 << 11) | 20) & 0xFu; }
#define XB_SPIN(cond, bar) do { unsigned _sp = 0; while (cond) { __builtin_amdgcn_s_sleep(1); \
    if ((++_sp & 255u) == 0u) { if (xb_ld(&(bar)[XB_TMO])) break; if (_sp > XB_SPIN_CAP) { atomicAdd(&(bar)[XB_TMO], 1u); break; } } } } while (0)

struct XcdBarrier {
    unsigned* bar; unsigned x;
    volatile LAS unsigned* st;
};

__device__ __forceinline__ XcdBarrier xcd_barrier_post(unsigned* bar, volatile LAS unsigned* st) {
    XcdBarrier b; b.bar = bar; b.x = xb_xcc_id(); b.st = st;
    if (threadIdx.x == 0) (void)xb_add(&bar[XB_XCNT(b.x)], 1u);
    return b;
}
__device__ __forceinline__ void xcd_barrier_complete(unsigned* bar, unsigned x, unsigned& nloc, unsigned& nx) {
    const unsigned G = gridDim.x * gridDim.y * gridDim.z;
    unsigned sum, cnt, mine, sp = 0u;
    for (;;) {
        sum = 0u; cnt = 0u; mine = 0u;
#pragma unroll
        for (unsigned j = 0; j < 16; ++j) { const unsigned c = xb_ld(&bar[XB_XCNT(j)]); sum += c; cnt += (c > 0u) ? 1u : 0u; mine = (j == x) ? c : mine; }
        if (sum == G) break;
        __builtin_amdgcn_s_sleep(1);
        if ((++sp & 255u) == 0u) { if (xb_ld(&bar[XB_TMO])) break; if (sp > XB_SPIN_CAP) { atomicAdd(&bar[XB_TMO], 1u); break; } }
    }
    nloc = mine > 0u ? mine : 1u; nx = cnt > 0u ? cnt : 1u;
}

__device__ __forceinline__ void xcd_barrier(const XcdBarrier& b) {
    asm volatile("s_waitcnt vmcnt(0)" ::: "memory");
    __syncthreads();
    if (threadIdx.x == 0) {
        unsigned* bar = b.bar;
        __builtin_amdgcn_s_waitcnt(0);
        unsigned nloc = b.st[0], nx = b.st[1];
        if (nloc == 0u) { xcd_barrier_complete(bar, b.x, nloc, nx); b.st[0] = nloc; b.st[1] = nx; }
        const unsigned old = xb_add(&bar[XB_XSUB(b.x)], 1u);
        const unsigned gen = old / nloc;
        if (old + 1u == (gen + 1u) * nloc) {
            __builtin_amdgcn_fence(__ATOMIC_RELEASE, "agent");
            asm volatile("s_waitcnt vmcnt(0)" ::: "memory");
            const unsigned og = xb_add(&bar[XB_TOP], 1u);
            const unsigned tg = og / nx;
            if (og + 1u == (tg + 1u) * nx) xb_add(&bar[XB_TOPGEN], 1u);
            else XB_SPIN(xb_ld(&bar[XB_TOPGEN]) == tg, bar);
            __builtin_amdgcn_fence(__ATOMIC_ACQUIRE, "agent");
            xb_add(&bar[XB_XGEN(b.x)], 1u);
            asm volatile("s_waitcnt vmcnt(0)" ::: "memory");
        } else {
            XB_SPIN(xb_ld(&bar[XB_XGEN(b.x)]) == gen, bar);
            __builtin_amdgcn_fence(__ATOMIC_ACQUIRE, "agent");
            asm volatile("s_waitcnt vmcnt(0)" ::: "memory");
        }
    }
    __syncthreads();
}


__device__ __forceinline__ void grid_bar(unsigned* cnt, unsigned target) {
    asm volatile("s_waitcnt vmcnt(0)" ::: "memory");
    __syncthreads();
    if (threadIdx.x == 0) {
        __builtin_amdgcn_fence(__ATOMIC_RELEASE, "agent");
        asm volatile("s_waitcnt vmcnt(0)" ::: "memory");
        __hip_atomic_fetch_add(cnt, 1u, __ATOMIC_RELAXED, __HIP_MEMORY_SCOPE_AGENT);
        while (__hip_atomic_load(cnt, __ATOMIC_RELAXED, __HIP_MEMORY_SCOPE_AGENT) < target) __builtin_amdgcn_s_sleep(2);
        __builtin_amdgcn_fence(__ATOMIC_ACQUIRE, "agent");
        asm volatile("s_waitcnt vmcnt(0)" ::: "memory");
    }
    __syncthreads();
}
__global__ void __launch_bounds__(512, 2) mega(Args a) {
    extern __shared__ __attribute__((aligned(16))) unsigned char lds_raw[];
    LAS unsigned char* lds = (LAS unsigned char*)lds_raw;
    const int tid = threadIdx.x, lane = tid & 63, wave = __builtin_amdgcn_readfirstlane(tid >> 6);
    const int G = gridDim.x, bx = blockIdx.x;
    const int vcu = (G % 8 == 0) ? (bx % 8) * (G / 8) + bx / 8 : bx;
    const int gw = vcu * 8 + wave, NGW = G * 8;
    unsigned char* ws = a.ws;
    bf16_t* WinT = (bf16_t*)(ws + WS_WIN); bf16_t* WbaT = (bf16_t*)(ws + WS_WBA); bf16_t* WblT = (bf16_t*)(ws + WS_WBL); bf16_t* WoT = (bf16_t*)(ws + WS_WO);
    bf16_t* WupT = (bf16_t*)(ws + WS_WUP); bf16_t* WdnT = (bf16_t*)(ws + WS_WDN); bf16_t* WRt = (bf16_t*)(ws + WS_WR); bf16_t* WIt = (bf16_t*)(ws + WS_WI);
    float* AGG = (float*)(ws + WS_AGG); float* RSS = (float*)(ws + WS_RSS);
    bf16_t* S0 = (bf16_t*)(ws + WS_SLOT0); bf16_t* S1 = (bf16_t*)(ws + WS_SLOT0 + SLOT); bf16_t* S2 = (bf16_t*)(ws + WS_SLOT0 + 2 * SLOT); bf16_t* S3 = (bf16_t*)(ws + WS_SLOT0 + 3 * SLOT);
    bf16_t* S4 = (bf16_t*)(ws + WS_SLOT0 + 4 * SLOT); bf16_t* S5 = (bf16_t*)(ws + WS_SLOT0 + 5 * SLOT);
    bf16_t *XN = S0, *BO = S0, *Qb = S1, *AO = S1, *Kb = S2, *MG = S2, *VT = S3, *TMP = S4, *XL = S4, *GG = S5, *HB = S5, *UP = S0;
    bf16_t* GA = (bf16_t*)(a.out + O_Y); bf16_t* GB = GA + (size_t)T * 1024;
    float* H = a.out + O_Y;
    const int lo = a.ph_lo, hi_ph = a.ph_hi;
#ifdef ONLYPH
#define IN(k) ((k) == ONLYPH && lo <= (k) && (k) < hi_ph)
#else
#define IN(k) (lo <= (k) && (k) < hi_ph)
#endif
    unsigned* barcnt = (unsigned*)(ws + WS_CTL);
    volatile LAS unsigned* xst = (volatile LAS unsigned*)(lds + LDS_BYTES - 16);
    if (tid < 2) xst[tid] = 0u;
    __syncthreads();
    const XcdBarrier xbar = xcd_barrier_post((unsigned*)(ws + WS_XB), xst);
    if (a.ph_lo < 0) cg::this_grid().sync();
#define SYNC(k) do { if (IN(k) && IN((k) + 1)) xcd_barrier(xbar); } while (0)

    if (IN(0)) for (int rep = 0; rep < REPN(0); ++rep) {
        LAS float* scr = (LAS float*)(lds + wave * 16384);
        constexpr int I_IN = 16 * 224, I_SQ = 16 * 32, I_UP = 16 * 128, I_DN = 64 * 32, I_G = 32;
        constexpr int NIT = I_IN + 3 * I_SQ + I_UP + I_DN + 2 * I_G;
        for (int it = gw; it < NIT; it += NGW) {
            int r = it;
            if (r < I_IN) { transpose_item(a.w_in, 1024, NIN, nullptr, WinT, scr, r, lane); continue; } r -= I_IN;
            if (r < I_SQ) { transpose_item(a.w_ba, 1024, 1024, nullptr, WbaT, scr, r, lane); continue; } r -= I_SQ;
            if (r < I_SQ) { transpose_item(a.w_bl, 1024, 1024, nullptr, WblT, scr, r, lane); continue; } r -= I_SQ;
            if (r < I_SQ) { transpose_item(a.w_o, 1024, 1024, nullptr, WoT, scr, r, lane); continue; } r -= I_SQ;
            if (r < I_UP) { transpose_item(a.w_up, 1024, FF, a.norm_mlp, WupT, scr, r, lane); continue; } r -= I_UP;
            if (r < I_DN) { transpose_item(a.w_down, FF, 1024, nullptr, WdnT, scr, r, lane); continue; } r -= I_DN;
            if (r < I_G) { transpose_item(a.w_rgate + (size_t)(r >> 1) * 4096, 64, 64, nullptr, WRt + (size_t)(r >> 1) * 4096, scr, r & 1, lane); continue; } r -= I_G;
            transpose_item(a.w_igate + (size_t)(r >> 1) * 4096, 64, 64, nullptr, WIt + (size_t)(r >> 1) * 4096, scr, r & 1, lane);
        }
        f32x4 g[4];
#pragma unroll
        for (int j = 0; j < 4; ++j) g[j] = ((const f32x4*)a.norm_mix)[lane + 64 * j];
        for (int m = gw; m < T; m += NGW) {
            const float* xr = (m < TP) ? a.x_prompt + (size_t)m * 1024 : a.x_sample + (size_t)(m - TP) * 1024;
            f32x4 v[4]; float s = 0.f;
#pragma unroll
            for (int j = 0; j < 4; ++j) { v[j] = ((const f32x4*)xr)[lane + 64 * j]; s += (v[j][0] * v[j][0] + v[j][1] * v[j][1]) + (v[j][2] * v[j][2] + v[j][3] * v[j][3]); }
            const float rstd = 1.0f / sqrtf(wave_sum(s) * (1.0f / 1024.0f) + EPS);
            u32x2* o = (u32x2*)(XN + (size_t)m * 1024);
#pragma unroll
            for (int j = 0; j < 4; ++j) { u32x2 w2; w2.x = pk2(v[j][0] * rstd * g[j][0], v[j][1] * rstd * g[j][1]); w2.y = pk2(v[j][2] * rstd * g[j][2], v[j][3] * rstd * g[j][3]); o[lane + 64 * j] = w2; }
        }
    }
    SYNC(0);
    if (IN(1)) for (int rep = 0; rep < REPN(1); ++rep) {
        pg8::Gemm g{XN, WinT, T, NIN, 1024, 1024}; pg8::StaticOrder S; S.init(T, NIN, G, bx);
        EpiIn E{Qb, Kb, VT, XL, GG, GA, GB, a.out};
        pg8::gemm_phase<EpiIn, pg8::StaticOrder, true, true>(lds, g, S, E);
    }
    SYNC(1);
    float* CARRY = (float*)(ws + WS_CARRY);
    LruP lp{XL, GG, WRt, WIt, BO, S2, S3, AGG, CARRY, a.conv_w, a.conv_b, a.b_rgate, a.b_igate, a.lru_lambda, a.state_conv, a.state_lru, a.out};
    if (IN(2)) {
        float lam;
        { const float q0 = a.lambda_q[lane], k0 = a.lambda_k[lane], q1 = a.lambda_q[64 + lane], k1 = a.lambda_k[64 + lane];
          lam = __expf(wave_sum(q0 * k0)) - __expf(wave_sum(q1 * k1)) + 0.2f; }
        AttP ap{Qb, Kb, VT, AO, a.cache_k, a.cache_v, a.head_gain, a.flags};
        { const int nsamp = (vcu < 256) ? (255 - vcu) / G + 1 : 0, npr = (vcu < 1024) ? 2 * ((1023 - vcu) / G + 1) : 0;
          const int ss = nsamp ? (vcu % (npr + 1)) : -1;
          int si = 0, pi = 0;
          for (int k = 0; k < npr + nsamp; ++k) {
              const bool is_s = (si < nsamp) && (k == ss || pi >= npr);
              if (is_s) { const int u = vcu + si * G; attn_unit<true>(ap, (LAS char*)lds, u >> 3, u & 7, 0, lam); ++si; }
              else { const int pr = vcu + (pi >> 1) * G, bh = pr >> 5, s = pr & 31; attn_unit<false>(ap, (LAS char*)lds, bh >> 3, bh & 7, (pi & 1) ? s : 63 - s, lam); ++pi; } } }
    }
    SYNC(2);
    if (IN(3)) {
        LAS char* scr = (LAS char*)lds + wave * 17408;
        for (int it = gw; it < 544 * 16; it += NGW) lru_item<false>(lp, scr, it >> 4, it & 15, lane);
    }
    SYNC(3);
    if (IN(4)) {
        if (vcu >= 4 && vcu < 12) {
            const int gt = (vcu - 4) * 512 + tid; const int b = gt >> 10, ch = gt & 1023; const float* ag = AGG + (size_t)(b * 128) * 2048 + ch; float* cr = CARRY + (size_t)(b * 128) * 1024 + ch; float h = 0.f;
#pragma unroll 16
            for (int j = 0; j < 128; ++j) { cr[(size_t)j * 1024] = h; h = ag[(size_t)j * 2048] * h + ag[(size_t)j * 2048 + 1024]; }
            asm volatile("s_waitcnt vmcnt(0)" ::: "memory"); __syncthreads();
            if (tid == 0) { __builtin_amdgcn_fence(__ATOMIC_RELEASE, "agent"); asm volatile("s_waitcnt vmcnt(0)" ::: "memory"); __hip_atomic_fetch_add(barcnt + 32, 1u, __ATOMIC_RELAXED, __HIP_MEMORY_SCOPE_AGENT); }
        }
        { pg8::Gemm g{AO, WbaT, T, 1024, 1024, 1024}; pg8::StaticOrder S; S.init(T, 1024, G, bx); EpiM1 E{GA, TMP};
          pg8::gemm_phase<EpiM1, pg8::StaticOrder, true, true>(lds, g, S, E); }
        while (__builtin_amdgcn_readfirstlane((int)__hip_atomic_load(barcnt + 32, __ATOMIC_RELAXED, __HIP_MEMORY_SCOPE_AGENT)) < (G < 8 ? G : 8)) __builtin_amdgcn_s_sleep(2);
        __builtin_amdgcn_fence(__ATOMIC_ACQUIRE, "agent"); asm volatile("s_waitcnt vmcnt(0)" ::: "memory");
        for (int it = gw; it < 544 * 16; it += NGW) lru_final_light(lp, it >> 4, it & 15, lane);
    }
    SYNC(4);
    if (IN(5)) for (int rep = 0; rep < REPN(5); ++rep) {
        { pg8::Gemm g{BO, WblT, T, 1024, 1024, 1024}; pg8::StaticOrder S; S.init(T, 1024, G, bx); EpiM2 E{GB, TMP, MG};
          pg8::gemm_phase<EpiM2, pg8::StaticOrder, true, true>(lds, g, S, E); }
    }
    SYNC(5);
    if (IN(6)) for (int rep = 0; rep < REPN(6); ++rep) {
        pg8::Gemm g{MG, WoT, T, 1024, 1024, 1024}; pg8::StaticOrder S; S.init(T, 1024, G, bx); EpiO E{a.x_prompt, a.x_sample, H, HB, RSS};
        pg8::gemm_phase<EpiO, pg8::StaticOrder, true, true>(lds, g, S, E);
    }
    SYNC(6);
    if (IN(7)) for (int rep = 0; rep < REPN(7); ++rep) {
        pg8::Gemm g{HB, WupT, T, FF, 1024, 1024}; pg8::StaticOrder S; S.init(T, FF, G, bx); EpiUp E{RSS, UP};
        pg8::gemm_phase<EpiUp, pg8::StaticOrder, true, true>(lds, g, S, E);
    }
    SYNC(7);
    if (IN(8)) {
        { pg8::Gemm g{UP, WdnT, TP, 1024, FF, FF}; pg8::StaticOrder S; S.init(TP, 1024, G, bx); EpiDown E{H};
          pg8::gemm_phase<EpiDown, pg8::StaticOrder, true, true>(lds, g, S, E); }
        { pg8::Gemm g{UP, WdnT, T, 1024, 512, FF}; SplitOrder S{G, bx}; EpiPart E{(float*)S4};
          pg8::gemm_phase<EpiPart, SplitOrder, true, true>(lds, g, S, E); }
    }
    SYNC(8);
    if (IN(9)) {
        f32x4 g[4];
#pragma unroll
        for (int j = 0; j < 4; ++j) g[j] = ((const f32x4*)a.norm_final)[lane + 64 * j];
        for (int m = gw; m < T; m += NGW) {
            f32x4* xr = (f32x4*)(H + (size_t)m * 1024);
            f32x4 v[4]; float s = 0.f;
#pragma unroll
            for (int j = 0; j < 4; ++j) v[j] = xr[lane + 64 * j];
            if (m >= TP) {
                const f32x4* pp = (const f32x4*)((const float*)S4 + (size_t)(m - TP) * 1024) + lane;
#pragma unroll
                for (int kc = 0; kc < 8; ++kc)
#pragma unroll
                    for (int j = 0; j < 4; ++j) v[j] += pp[(size_t)kc * 2048 * 256 + 64 * j];
            }
#pragma unroll
            for (int j = 0; j < 4; ++j) s += (v[j][0] * v[j][0] + v[j][1] * v[j][1]) + (v[j][2] * v[j][2] + v[j][3] * v[j][3]);
            const float rstd = 1.0f / sqrtf(wave_sum(s) * (1.0f / 1024.0f) + EPS);
#pragma unroll
            for (int j = 0; j < 4; ++j) xr[lane + 64 * j] = v[j] * rstd * g[j];
        }
    }
#undef IN
#undef SYNC
}

constexpr int NPH = 10;
#ifndef MK_LAUNCHES
#define MK_LAUNCHES 1
#endif
extern "C" void kernel_launch(void* const* d_in, const int* in_sizes, int n_in, void* d_out, int out_size, void* d_ws, size_t ws_size, hipStream_t stream) {
    static int grid = 0;
    if (grid == 0) {
        if (n_in != 25 || ws_size < WS_END) { fprintf(stderr, "kernel_launch: unexpected n_in %d / ws %zu (need %zu)\n", n_in, ws_size, (size_t)WS_END); grid = -1; return; }
        int dev = 0, cus = 0, per_cu = 0;
        hipGetDevice(&dev); hipDeviceGetAttribute(&cus, hipDeviceAttributeMultiprocessorCount, dev);
        if (hipFuncSetAttribute((const void*)mega, hipFuncAttributeMaxDynamicSharedMemorySize, LDS_BYTES) != hipSuccess) { fprintf(stderr, "hipFuncSetAttribute failed\n"); grid = -1; return; }
        hipOccupancyMaxActiveBlocksPerMultiprocessor(&per_cu, (const void*)mega, 512, LDS_BYTES);
        if (per_cu < 1) { fprintf(stderr, "occupancy query says %d\n", per_cu); per_cu = 1; }
        (void)hipGetLastError();
        grid = cus * 1;
    }
    if (grid < 0) return;
    if (hipMemsetAsync((char*)d_ws + WS_CTL, 0, 256, stream) != hipSuccess) { fprintf(stderr, "memset failed\n"); return; }
    if (hipMemsetAsync((char*)d_ws + WS_XB, 0, 16384, stream) != hipSuccess) { fprintf(stderr, "memset failed\n"); return; }
    Args a{};
    const float** pf = (const float**)&a;
    for (int i = 0; i < 25; ++i) pf[i] = (const float*)d_in[i];
    a.out = (float*)d_out; a.ws = (unsigned char*)d_ws;
#if MK_LAUNCHES == 1
#ifdef PROBE_PREFIX
    { a.ph_lo = 0; a.ph_hi = PROBE_PREFIX; a.flags = PROBE_FLAGS; void* args0[] = {&a};
      if (hipLaunchCooperativeKernel((const void*)mega, dim3(grid), dim3(512), args0, LDS_BYTES, stream) != hipSuccess) fprintf(stderr, "probe launch failed\n");
      if (hipMemsetAsync((char*)d_ws + WS_CTL, 0, 256, stream) != hipSuccess) fprintf(stderr, "memset failed\n"); }
#endif
    a.ph_lo = 0; a.ph_hi = NPH; a.flags = 0;
    void* args[] = {&a};
    hipError_t e = hipLaunchCooperativeKernel((const void*)mega, dim3(grid), dim3(512), args, LDS_BYTES, stream);
    if (e != hipSuccess) fprintf(stderr, "cooperative launch failed: %s (grid %d)\n", hipGetErrorString(e), grid);
#else
    for (int k = 0; k < NPH; ++k) { a.ph_lo = k; a.ph_hi = k + 1; hipLaunchKernelGGL(mega, dim3(grid), dim3(512), LDS_BYTES, stream, a); }
#endif
}
```

```cpp
#include <hip/hip_runtime.h>
#include <hip/hip_cooperative_groups.h>
#include <cstdio>
#include <cstdint>
namespace cg = cooperative_groups;
namespace pg8 {
#define PG8_LAS __attribute__((address_space(3)))
typedef unsigned short bf16_t;
typedef short bf16x8 __attribute__((ext_vector_type(8)));
typedef float f32x4 __attribute__((ext_vector_type(4)));
typedef unsigned u32x4 __attribute__((ext_vector_type(4)));
constexpr int BM = 256, BK = 64, HALF = 128, HTB = HALF * BK * 2  , STAGE_BYTES = 8 * HTB, NXCD = 8, WGM = 8;

__host__ __device__ __forceinline__ int lds_byte(int r, int c) { const int st = (r >> 4) * 2 + (c >> 5), rr = r & 15, cc = c & 31, ob = rr * 64 + cc * 2; return st * 1024 + (ob ^ (((ob >> 9) & 1) << 5)); }
__host__ __device__ __forceinline__ void stage_rc(int b, int& R, int& C) { const int st = b / 1024, sb = b % 1024, swz = sb ^ (((sb >> 9) & 1) << 5); R = (st >> 1) * 16 + swz / 64; C = (st & 1) * 32 + (swz % 64) / 2; }
__host__ __device__ __forceinline__ int perm32(int rho) { const int n = rho >> 4, i = rho & 15; return 8 * (i >> 2) + 4 * n + (i & 3); }

struct Unit { int pm, pn, kc; };
struct Gemm { const bf16_t* A; const bf16_t* Bt; int M, N, K, ld; };

struct StaticOrder {
    int nM, nN, nwg, G, c;
    __host__ __device__ void init(int M, int N, int G_, int c_) { nM = M / BM; nN = N / BM; nwg = nM * nN; G = G_; c = c_; }
    __host__ __device__ bool next(int i, Unit& u) const {
        const long L = (long)i * G + c; if (L >= nwg) return false;
        int wgid = (int)L; { const int q = nwg / NXCD, r = nwg % NXCD, xcd = wgid % NXCD, off = wgid / NXCD; wgid = (xcd < r ? xcd * (q + 1) : r * (q + 1) + (xcd - r) * q) + off; }
        const int nig = WGM * nN, gid = wgid / nig, fm = gid * WGM, gsz = (nM - fm) < WGM ? (nM - fm) : WGM;
        u.pm = fm + ((wgid % nig) % gsz); u.pn = (wgid % nig) / gsz; u.kc = 0; return true;
    }
    __device__ __forceinline__ void a_ready(const Unit&) const {}
    __device__ __forceinline__ void done(const Unit&) const {}
};

template <class Epi, class Sched, bool ALIGN_EPI = false, bool SP2 = false>
__device__ __forceinline__ void gemm_phase(PG8_LAS unsigned char* lds, const Gemm g, const Sched& S, const Epi& E) {
    const int tid = threadIdx.x, wid = __builtin_amdgcn_readfirstlane(tid >> 6), lane = tid & 63, wr = wid >> 2, wc = wid & 3, fr = lane & 15, fq = lane >> 4;
    const int K = g.ld, nt = g.K / BK; const size_t kcb = (size_t)g.K * 2;
    unsigned voffA[2], voffB[2];
#pragma unroll
    for (int i = 0; i < 2; ++i) { int R, C; stage_rc(tid * 16 + i * 8192, R, C); const int Rb = Epi::PERM ? ((R & ~31) + perm32(R & 31)) : R;
        voffA[i] = (unsigned)(R * K + C) * 2u; voffB[i] = (unsigned)(Rb * K + C) * 2u; }
    const size_t kstep = (size_t)(BK * 2);
    const size_t hstep = (size_t)HALF * K * 2;
    const size_t tstep = 2 * hstep;
    const unsigned ldsw = (unsigned)wid * 1024u;
    const int aoff = lds_byte(wr * 64 + fr, fq * 8), boff = lds_byte(wc * 32 + fr, fq * 8);
#define PG8_SA(b, h) (((b) * 2 + (h)) * HTB)
#define PG8_SB(b, h) ((4 + (b) * 2 + (h)) * HTB)
#define PG8_STAGE(bufoff, gbase, voff) do { _Pragma("unroll") for (int _i = 0; _i < 2; ++_i) \
        __builtin_amdgcn_global_load_lds((const unsigned*)((const char*)(gbase) + (voff)[_i]), (PG8_LAS unsigned*)(lds + (bufoff) + ldsw + _i * 8192), 16, 0, 0); } while (0)
#define PG8_LDA(dst, b, h) do { _Pragma("unroll") for (int m = 0; m < 4; ++m) _Pragma("unroll") for (int k = 0; k < 2; ++k) dst[m][k] = *(const PG8_LAS bf16x8*)(lds + PG8_SA(b, h) + aoff + m * 2048 + k * 1024); } while (0)
#define PG8_LDB(dst, b, h) do { _Pragma("unroll") for (int n = 0; n < 2; ++n) _Pragma("unroll") for (int k = 0; k < 2; ++k) dst[n][k] = *(const PG8_LAS bf16x8*)(lds + PG8_SB(b, h) + boff + n * 2048 + k * 1024); } while (0)
#define PG8_MMA(ai, bj, At, Bt) do { __builtin_amdgcn_s_setprio(1); _Pragma("unroll") for (int m = 0; m < 4; ++m) _Pragma("unroll") for (int n = 0; n < 2; ++n) _Pragma("unroll") for (int k = 0; k < 2; ++k) \
        acc[ai][bj][m][n] = __builtin_amdgcn_mfma_f32_16x16x32_bf16(Bt[n][k], At[m][k], acc[ai][bj][m][n], 0, 0, 0); __builtin_amdgcn_s_setprio(0); } while (0)
#define PG8_WAIT_V(n) asm volatile("s_waitcnt vmcnt(" #n ")" ::: "memory")
#define PG8_WAIT_L(n) asm volatile("s_waitcnt lgkmcnt(" #n ")" ::: "memory")
#define PG8_BAR __builtin_amdgcn_s_barrier()
#define PG8_SCHED __builtin_amdgcn_sched_barrier(0)
    Unit cur, nxt; int ui = 0;
    if (!S.next(0, cur)) return;
    f32x4 acc[2][2][4][2];
#pragma unroll
    for (int a = 0; a < 2; ++a)
#pragma unroll
        for (int b = 0; b < 2; ++b)
#pragma unroll
            for (int m = 0; m < 4; ++m)
#pragma unroll
                for (int n = 0; n < 2; ++n) acc[a][b][m][n] = (f32x4){0.f, 0.f, 0.f, 0.f};
    bf16x8 At[4][2], B0[2][2], B1[2][2];
    const char* cA = (const char*)g.A + (size_t)cur.pm * tstep + (size_t)cur.kc * kcb; const char* cB = (const char*)g.Bt + (size_t)cur.pn * tstep + (size_t)cur.kc * kcb;
    S.a_ready(cur);
    if constexpr (SP2) {
        PG8_STAGE(PG8_SB(0, 0), cB, voffB); PG8_STAGE(PG8_SB(0, 1), cB + hstep, voffB); PG8_STAGE(PG8_SA(0, 0), cA, voffA); PG8_STAGE(PG8_SA(0, 1), cA + hstep, voffA);
        if (wr == 1) PG8_BAR;
        PG8_WAIT_V(2); PG8_BAR;
        PG8_STAGE(PG8_SB(1, 0), cB + kstep, voffB); PG8_STAGE(PG8_SA(1, 0), cA + kstep, voffA); PG8_STAGE(PG8_SB(1, 1), cB + hstep + kstep, voffB);
        PG8_WAIT_V(6); PG8_BAR;
    } else {
        PG8_STAGE(PG8_SB(0, 0), cB, voffB); PG8_STAGE(PG8_SA(0, 0), cA, voffA); PG8_STAGE(PG8_SB(0, 1), cB + hstep, voffB); PG8_STAGE(PG8_SA(0, 1), cA + hstep, voffA);
        if (wr == 1) PG8_BAR;
        PG8_WAIT_V(4); PG8_BAR;
        PG8_STAGE(PG8_SB(1, 0), cB + kstep, voffB); PG8_STAGE(PG8_SA(1, 0), cA + kstep, voffA); PG8_STAGE(PG8_SB(1, 1), cB + hstep + kstep, voffB);
        PG8_WAIT_V(6); PG8_BAR;
    }
    for (;;) {
        const bool has_next = S.next(ui + 1, nxt);
        const char* nA = has_next ? (const char*)g.A + (size_t)nxt.pm * tstep + (size_t)nxt.kc * kcb : cA; const char* nB = has_next ? (const char*)g.Bt + (size_t)nxt.pn * tstep + (size_t)nxt.kc * kcb : cB;
        for (int t = 0; t < nt; t += 2) {
            const bool last = (t == nt - 2);
            const char* a1 = cA + (size_t)(t + 1) * kstep;
            const char* a2 = last ? nA : cA + (size_t)(t + 2) * kstep; const char* b2 = last ? nB : cB + (size_t)(t + 2) * kstep;
            const char* a3 = a2 + kstep; const char* b3 = b2 + kstep;
            if (last && has_next) S.a_ready(nxt);
            if constexpr (SP2) {
            PG8_LDB(B0, 0, 0); PG8_LDB(B1, 0, 1); PG8_SCHED; PG8_LDA(At, 0, 0); PG8_STAGE(PG8_SA(1, 1), a1 + hstep, voffA);
            PG8_WAIT_V(8); PG8_WAIT_L(0); PG8_BAR; PG8_MMA(0, 0, At, B0); PG8_MMA(0, 1, At, B1); PG8_BAR; PG8_SCHED;
            PG8_LDA(At, 0, 1); PG8_STAGE(PG8_SB(0, 0), b2, voffB); PG8_STAGE(PG8_SB(0, 1), b2 + hstep, voffB); PG8_STAGE(PG8_SA(0, 0), a2, voffA);
            PG8_WAIT_V(8); PG8_WAIT_L(0); PG8_BAR; PG8_MMA(1, 0, At, B0); PG8_MMA(1, 1, At, B1); PG8_BAR; PG8_SCHED;
            PG8_LDB(B0, 1, 0); PG8_LDB(B1, 1, 1); PG8_SCHED; PG8_LDA(At, 1, 0); PG8_STAGE(PG8_SA(0, 1), a2 + hstep, voffA);
            PG8_WAIT_V(8); PG8_WAIT_L(0); PG8_BAR; PG8_MMA(0, 0, At, B0); PG8_MMA(0, 1, At, B1); PG8_BAR; PG8_SCHED;
            PG8_LDA(At, 1, 1); PG8_STAGE(PG8_SB(1, 0), b3, voffB); PG8_STAGE(PG8_SB(1, 1), b3 + hstep, voffB); PG8_STAGE(PG8_SA(1, 0), a3, voffA);
            PG8_WAIT_V(8); PG8_WAIT_L(0); PG8_BAR; PG8_MMA(1, 0, At, B0); PG8_MMA(1, 1, At, B1); PG8_BAR; PG8_SCHED;
            } else {
            PG8_LDB(B0, 0, 0); PG8_SCHED; PG8_LDA(At, 0, 0); PG8_STAGE(PG8_SA(1, 1), a1 + hstep, voffA);
            PG8_WAIT_L(8); PG8_BAR; PG8_WAIT_L(0); PG8_MMA(0, 0, At, B0); PG8_BAR; PG8_SCHED;
            PG8_LDB(B1, 0, 1); PG8_STAGE(PG8_SB(0, 0), b2, voffB);
            PG8_BAR; PG8_WAIT_L(0); PG8_MMA(0, 1, At, B1); PG8_BAR;
            PG8_LDA(At, 0, 1); PG8_STAGE(PG8_SA(0, 0), a2, voffA);
            PG8_BAR; PG8_WAIT_L(0); PG8_MMA(1, 0, At, B0); PG8_BAR; PG8_SCHED;
            PG8_STAGE(PG8_SB(0, 1), b2 + hstep, voffB);
            PG8_WAIT_V(6); PG8_BAR; PG8_MMA(1, 1, At, B1); PG8_BAR;
            PG8_LDB(B0, 1, 0); PG8_SCHED; PG8_LDA(At, 1, 0); PG8_STAGE(PG8_SA(0, 1), a2 + hstep, voffA);
            PG8_WAIT_L(8); PG8_BAR; PG8_WAIT_L(0); PG8_MMA(0, 0, At, B0); PG8_BAR; PG8_SCHED;
            PG8_LDB(B1, 1, 1); PG8_STAGE(PG8_SB(1, 0), b3, voffB);
            PG8_BAR; PG8_WAIT_L(0); PG8_MMA(0, 1, At, B1); PG8_BAR;
            PG8_LDA(At, 1, 1); PG8_STAGE(PG8_SA(1, 0), a3, voffA);
            PG8_BAR; PG8_WAIT_L(0); PG8_MMA(1, 0, At, B0); PG8_BAR; PG8_SCHED;
            PG8_STAGE(PG8_SB(1, 1), b3 + hstep, voffB);
            PG8_WAIT_V(6); PG8_BAR; PG8_MMA(1, 1, At, B1); PG8_BAR;
            }
        }
        if constexpr (ALIGN_EPI) { if (wr == 0) PG8_BAR; }
        if constexpr (!Epi::AFTER_DRAIN) { E(acc, cur, wr, wc, fr, fq); S.done(cur); }
        if (!has_next) break;
#pragma unroll
        for (int a = 0; a < 2; ++a)
#pragma unroll
            for (int b = 0; b < 2; ++b)
#pragma unroll
                for (int m = 0; m < 4; ++m)
#pragma unroll
                    for (int n = 0; n < 2; ++n) acc[a][b][m][n] = (f32x4){0.f, 0.f, 0.f, 0.f};
        cur = nxt; cA = nA; cB = nB; ++ui;
        if constexpr (ALIGN_EPI) { if (wr == 1) PG8_BAR; }
    }
    PG8_WAIT_V(0);
    if constexpr (!ALIGN_EPI) { if (wr == 0) PG8_BAR; }
    PG8_BAR;
    if constexpr (Epi::AFTER_DRAIN) { E.fused(acc, cur, wr, wc, fr, fq, lds, wid, lane); S.done(cur); }
#undef PG8_SA
#undef PG8_SB
#undef PG8_STAGE
#undef PG8_LDA
#undef PG8_LDB
#undef PG8_MMA
#undef PG8_WAIT_V
#undef PG8_WAIT_L
#undef PG8_BAR
#undef PG8_SCHED
}
}

#define LAS __attribute__((address_space(3)))
typedef unsigned short bf16_t;
typedef short bf16x8 __attribute__((ext_vector_type(8)));
typedef short s16x4 __attribute__((ext_vector_type(4)));
typedef float f32x4 __attribute__((ext_vector_type(4)));
typedef float f32x16 __attribute__((ext_vector_type(16)));
typedef unsigned u32x4 __attribute__((ext_vector_type(4)));
typedef unsigned u32x2 __attribute__((ext_vector_type(2)));
typedef float f32x2_t __attribute__((ext_vector_type(2)));
typedef __bf16 bf16x2_t __attribute__((ext_vector_type(2)));

constexpr int T = 34816, TP = 32768, DM = 1024, NIN = 7168, FF = 4096, SEQP = 8192;
constexpr float EPS = 1e-6f;
constexpr float QSCALE = 0.125f * 1.4426950408889634f;
constexpr size_t O_Y = 0, O_KP = 35651584, O_VP = 69206016, O_CP = 102760448, O_LP = 102772736, O_KS = 102776832, O_VS = 104873984, O_CS = 106971136, O_LS = 107069440;
constexpr size_t SLOT = (size_t)T * 1024 * 2;
constexpr size_t WS_WIN = 0, WS_WBA = 14680064, WS_WBL = WS_WBA + 2097152, WS_WO = WS_WBL + 2097152, WS_WUP = WS_WO + 2097152, WS_WDN = WS_WUP + 8388608,
                 WS_WR = WS_WDN + 8388608, WS_WI = WS_WR + 131072, WS_AGG = WS_WI + 131072, WS_RSS = WS_AGG + 4194304, WS_CTL = WS_RSS + (size_t)34816 * 64, WS_CARRY = WS_CTL + 256, WS_XB = WS_CARRY + 2097152, WS_SLOT0 = 50331648;
static_assert(WS_XB + 16384 <= WS_SLOT0, "ws map");
constexpr size_t WS_END = WS_SLOT0 + 6 * SLOT;
constexpr int LDS_BYTES = 147456;
#ifndef PROBE_FLAGS
#define PROBE_FLAGS 0
#endif
#ifndef REPMASK
#define REPMASK 0
#endif
#define REPN(k) ((((REPMASK) >> (k)) & 1) ? 2 : 1)

struct Args {
    const float *x_prompt, *x_sample, *cache_k, *cache_v, *state_conv, *state_lru, *norm_mix, *norm_mlp, *norm_final, *w_in, *lambda_q, *lambda_k, *head_gain,
        *conv_w, *conv_b, *w_rgate, *b_rgate, *w_igate, *b_igate, *lru_lambda, *w_ba, *w_bl, *w_o, *w_up, *w_down;
    float* out; unsigned char* ws; int ph_lo, ph_hi, flags, pad;
};

__device__ __forceinline__ unsigned pk2(float lo, float hi) { f32x2_t v = {lo, hi}; bf16x2_t b = __builtin_convertvector(v, bf16x2_t); return __builtin_bit_cast(unsigned, b); }
__device__ __forceinline__ bf16_t f2bf(float f) { __bf16 b = (__bf16)f; return __builtin_bit_cast(unsigned short, b); }
__device__ __forceinline__ float bf2f(bf16_t u) { return __uint_as_float(((unsigned)u) << 16); }
__device__ __forceinline__ float bflo(unsigned u) { return __uint_as_float(u << 16); }
__device__ __forceinline__ float bfhi(unsigned u) { return __uint_as_float(u & 0xffff0000u); }
__device__ __forceinline__ float fsigmoid(float x) { return __builtin_amdgcn_rcpf(1.0f + __builtin_amdgcn_exp2f(-1.4426950408889634f * x)); }
__device__ __forceinline__ float gelu_tanh(float x) { const float y = 0.7978845608028654f * (x + 0.044715f * x * x * x); return x * fsigmoid(2.0f * y); }
__device__ __forceinline__ u32x4 pack8(const f32x4& a, const f32x4& b) { u32x4 w; w.x = pk2(a[0], a[1]); w.y = pk2(a[2], a[3]); w.z = pk2(b[0], b[1]); w.w = pk2(b[2], b[3]); return w; }
__device__ __forceinline__ int crow(int r, int hi) { return (r & 3) + 8 * (r >> 2) + 4 * hi; }
#define LDS_FENCE() asm volatile("s_waitcnt lgkmcnt(0)" ::: "memory")
#define MFMA32(a, b, c) __builtin_amdgcn_mfma_f32_32x32x16_bf16((a), (b), (c), 0, 0, 0)

using pg8::Unit;
#define EPI_LOOP(...) _Pragma("unroll") for (int ai = 0; ai < 2; ++ai) _Pragma("unroll") for (int m = 0; m < 4; ++m) { const int row = rbase + ai * 128 + m * 16; \
    _Pragma("unroll") for (int bj = 0; bj < 2; ++bj) { const int col = cbase + bj * 128; const f32x4 v0 = acc[ai][bj][m][0], v1 = acc[ai][bj][m][1]; __VA_ARGS__ } }

struct EpiIn {
    static constexpr bool PERM = true, AFTER_DRAIN = false;
    bf16_t *Q, *Kb, *VT, *XL, *GG, *GA, *GB; float* out;
    __device__ __forceinline__ void operator()(const f32x4 (&acc)[2][2][4][2], const Unit& u, int wr, int wc, int fr, int fq) const {
        const int sec = u.pn >> 2;
        const int cbase = (u.pn & 3) * 256 + wc * 32 + 8 * fq;
        const int rbase = u.pm * 256 + wr * 64 + fr;
        const bool prompt = u.pm < 128;
        if (sec == 0) {
            EPI_LOOP({ *(u32x4*)(Q + (size_t)row * 1024 + col) = pack8(v0 * QSCALE, v1 * QSCALE); })
        } else if (sec == 1) {
            float* ko = prompt ? out + O_KP : out + O_KS - (size_t)TP * 1024;
            EPI_LOOP({ float* o = ko + (size_t)row * 1024 + col; *(f32x4*)o = v0; *(f32x4*)(o + 4) = v1; *(u32x4*)(Kb + (size_t)row * 1024 + col) = pack8(v0, v1); })
        } else if (sec == 2) {
            float* vo = prompt ? out + O_VP : out + O_VS - (size_t)TP * 1024;
            EPI_LOOP({ float* o = vo + (size_t)row * 1024 + col; *(f32x4*)o = v0; *(f32x4*)(o + 4) = v1; *(u32x4*)(VT + (size_t)row * 1024 + col) = pack8(v0, v1); })
        } else if (sec == 3) {
            EPI_LOOP({ *(u32x4*)(XL + (size_t)row * 1024 + col) = pack8(v0, v1);
                if (prompt) { const int pos = row & (SEQP - 1); if (pos >= SEQP - 3) { float* o = out + O_CP + (size_t)((row >> 13) * 3 + pos - (SEQP - 3)) * 1024 + col; *(f32x4*)o = v0; *(f32x4*)(o + 4) = v1; } }
                else { const int rs = row - TP; const int pos = rs & 63; if (pos >= 61) { float* o = out + O_CS + (size_t)((rs >> 6) * 3 + pos - 61) * 1024 + col; *(f32x4*)o = v0; *(f32x4*)(o + 4) = v1; } } })
        } else if (sec == 4) {
            EPI_LOOP({ f32x4 a, b; _Pragma("unroll") for (int j = 0; j < 4; ++j) { a[j] = gelu_tanh(v0[j]); b[j] = gelu_tanh(v1[j]); }
                *(u32x4*)(GG + (size_t)row * 1024 + col) = pack8(a, b); })
        } else {
            bf16_t* G = (sec == 5) ? GA : GB;
            EPI_LOOP({ f32x4 a, b; _Pragma("unroll") for (int j = 0; j < 4; ++j) { a[j] = fsigmoid(v0[j]); b[j] = fsigmoid(v1[j]); }
                *(u32x4*)(G + (size_t)row * 1024 + col) = pack8(a, b); })
        }
    }
};
__device__ __forceinline__ void unpack8(const u32x4 w, f32x4& a, f32x4& b) { a[0] = bflo(w.x); a[1] = bfhi(w.x); a[2] = bflo(w.y); a[3] = bfhi(w.y); b[0] = bflo(w.z); b[1] = bfhi(w.z); b[2] = bflo(w.w); b[3] = bfhi(w.w); }
struct EpiM1 {
    static constexpr bool PERM = true, AFTER_DRAIN = false;
    const bf16_t* G; bf16_t* O;
    __device__ __forceinline__ void operator()(const f32x4 (&acc)[2][2][4][2], const Unit& u, int wr, int wc, int fr, int fq) const {
        const int cbase = u.pn * 256 + wc * 32 + 8 * fq, rbase = u.pm * 256 + wr * 64 + fr;
        EPI_LOOP({ f32x4 g0, g1; unpack8(*(const u32x4*)(G + (size_t)row * 1024 + col), g0, g1); *(u32x4*)(O + (size_t)row * 1024 + col) = pack8(g0 * v0, g1 * v1); })
    }
};
struct EpiM2 {
    static constexpr bool PERM = true, AFTER_DRAIN = false;
    const bf16_t* G; const bf16_t* Tm; bf16_t* O;
    __device__ __forceinline__ void operator()(const f32x4 (&acc)[2][2][4][2], const Unit& u, int wr, int wc, int fr, int fq) const {
        const int cbase = u.pn * 256 + wc * 32 + 8 * fq, rbase = u.pm * 256 + wr * 64 + fr;
        EPI_LOOP({ f32x4 g0, g1, t0, t1; unpack8(*(const u32x4*)(G + (size_t)row * 1024 + col), g0, g1); unpack8(*(const u32x4*)(Tm + (size_t)row * 1024 + col), t0, t1);
            *(u32x4*)(O + (size_t)row * 1024 + col) = pack8(t0 + g0 * v0, t1 + g1 * v1); })
    }
};
struct EpiO {
    static constexpr bool PERM = true, AFTER_DRAIN = false;
    const float *xp, *xs; float* H; bf16_t* HB; float* RSS;
    __device__ __forceinline__ void operator()(const f32x4 (&acc)[2][2][4][2], const Unit& u, int wr, int wc, int fr, int fq) const {
        const int cbase = u.pn * 256 + wc * 32 + 8 * fq, rbase = u.pm * 256 + wr * 64 + fr;
        const float* xb = (u.pm < 128) ? xp : xs - (size_t)TP * 1024;
#pragma unroll
        for (int ai = 0; ai < 2; ++ai)
#pragma unroll
            for (int m = 0; m < 4; ++m) { const int row = rbase + ai * 128 + m * 16; float ss = 0.f;
#pragma unroll
                for (int bj = 0; bj < 2; ++bj) { const int col = cbase + bj * 128; const float* xr = xb + (size_t)row * 1024 + col;
                    const f32x4 h0 = *(const f32x4*)xr + acc[ai][bj][m][0], h1 = *(const f32x4*)(xr + 4) + acc[ai][bj][m][1];
                    float* o = H + (size_t)row * 1024 + col; *(f32x4*)o = h0; *(f32x4*)(o + 4) = h1;
                    *(u32x4*)(HB + (size_t)row * 1024 + col) = pack8(h0, h1);
                    ss += (h0[0] * h0[0] + h0[1] * h0[1]) + (h0[2] * h0[2] + h0[3] * h0[3]) + (h1[0] * h1[0] + h1[1] * h1[1]) + (h1[2] * h1[2] + h1[3] * h1[3]); }
                ss += __shfl_xor(ss, 16); ss += __shfl_xor(ss, 32);
                if (fq == 0) RSS[(size_t)row * 16 + u.pn * 4 + wc] = ss; }
    }
};
struct EpiUp {
    static constexpr bool PERM = true, AFTER_DRAIN = false;
    const float* RSS; bf16_t* UP;
    __device__ __forceinline__ void operator()(const f32x4 (&acc)[2][2][4][2], const Unit& u, int wr, int wc, int fr, int fq) const {
        const int cbase = u.pn * 256 + wc * 32 + 8 * fq, rbase = u.pm * 256 + wr * 64 + fr;
#pragma unroll
        for (int ai = 0; ai < 2; ++ai)
#pragma unroll
            for (int m = 0; m < 4; ++m) { const int row = rbase + ai * 128 + m * 16;
                const f32x4* rp = (const f32x4*)(RSS + (size_t)row * 16); const f32x4 s = (rp[0] + rp[1]) + (rp[2] + rp[3]);
                const float rstd = __builtin_amdgcn_rsqf(((s[0] + s[1]) + (s[2] + s[3])) * (1.0f / 1024.0f) + EPS);
#pragma unroll
                for (int bj = 0; bj < 2; ++bj) { const int col = cbase + bj * 128; f32x4 a = acc[ai][bj][m][0] * rstd, b = acc[ai][bj][m][1] * rstd;
#pragma unroll
                    for (int j = 0; j < 4; ++j) { a[j] = fmaxf(a[j], 0.f); a[j] *= a[j]; b[j] = fmaxf(b[j], 0.f); b[j] *= b[j]; }
                    *(u32x4*)(UP + (size_t)row * FF + col) = pack8(a, b); } }
    }
};
struct EpiDown {
    static constexpr bool PERM = true, AFTER_DRAIN = false;
    float* H;
    __device__ __forceinline__ void operator()(const f32x4 (&acc)[2][2][4][2], const Unit& u, int wr, int wc, int fr, int fq) const {
        const int cbase = u.pn * 256 + wc * 32 + 8 * fq, rbase = u.pm * 256 + wr * 64 + fr;
        EPI_LOOP({ float* o = H + (size_t)row * 1024 + col; const f32x4 h0 = *(const f32x4*)o + v0, h1 = *(const f32x4*)(o + 4) + v1; *(f32x4*)o = h0; *(f32x4*)(o + 4) = h1; })
    }
};

struct EpiPart {
    static constexpr bool PERM = true, AFTER_DRAIN = false;
    float* PART;
    __device__ __forceinline__ void operator()(const f32x4 (&acc)[2][2][4][2], const Unit& u, int wr, int wc, int fr, int fq) const {
        const int cbase = u.pn * 256 + wc * 32 + 8 * fq, rbase = u.pm * 256 + wr * 64 + fr;
        float* pb = PART + (size_t)u.kc * 2048 * 1024;
        EPI_LOOP({ float* o = pb + (size_t)(row - TP) * 1024 + col; *(f32x4*)o = v0; *(f32x4*)(o + 4) = v1; })
    }
};
struct SplitOrder {
    int G, c;
    __device__ __forceinline__ bool next(int i, Unit& u) const { const int L = i * G + c; if (L >= 256) return false; u.pm = 128 + (L >> 5); const int r = L & 31; u.pn = r >> 3; u.kc = r & 7; return true; }
    __device__ __forceinline__ void a_ready(const Unit&) const {}
    __device__ __forceinline__ void done(const Unit&) const {}
};
__device__ __forceinline__ float wave_sum(float v) {
#pragma unroll
    for (int o = 1; o < 64; o <<= 1) v += __shfl_xor(v, o);
    return v;
}
__device__ __forceinline__ void transpose_item(const float* __restrict__ W, int K, int N, const float* __restrict__ kscale, bf16_t* WT, LAS float* scr, int item, int lane) {
    const int nblk = N / 32, kb = item / nblk, nb = item % nblk, k0 = 64 * kb, n0 = 32 * nb;
#pragma unroll 8
    for (int i = 0; i < 32; ++i) { const int kk = 2 * i + (lane >> 5); float v = W[(size_t)(k0 + kk) * N + n0 + (lane & 31)]; if (kscale) v *= kscale[k0 + kk]; scr[kk * 33 + (lane & 31)] = v; }
    LDS_FENCE();
    const int c = lane & 7;
#pragma unroll
    for (int j = 0; j < 4; ++j) { const int n = (lane >> 3) + 8 * j; const LAS float* s = scr + (8 * c) * 33 + n;
        u32x4 o; o.x = pk2(s[0 * 33], s[1 * 33]); o.y = pk2(s[2 * 33], s[3 * 33]); o.z = pk2(s[4 * 33], s[5 * 33]); o.w = pk2(s[6 * 33], s[7 * 33]);
        *(u32x4*)(WT + (size_t)(n0 + n) * K + k0 + 8 * c) = o; }
    LDS_FENCE();
}

struct LruP { const bf16_t *XL, *GG, *WRt, *WIt; bf16_t* BO; bf16_t *LA, *U; float* AGG; const float* CARRY; const float *conv_w, *conv_b, *b_r, *b_i, *lam, *state_conv, *state_lru; float* out; };
template <bool FINAL>
__device__ __forceinline__ void lru_item(const LruP& p, LAS char* scr, int tl, int n, int lane) {
    const int l31 = lane & 31, hi = lane >> 5;
    const bool samp = tl >= 512; const int bs = tl - 512, c = tl & 127, bp = tl >> 7;
    const size_t tok0 = (size_t)tl * 64;
    LAS bf16_t* sx = (LAS bf16_t*)scr;
    const unsigned lvoff = (unsigned)((4 * hi * 1024 + l31) * 2);
    {
        const int ch = n * 64 + lane;
        const float w0 = p.conv_w[ch], w1 = p.conv_w[1024 + ch], w2 = p.conv_w[2048 + ch], w3 = p.conv_w[3072 + ch], cb = p.conv_b[ch];
        float x0, x1, x2;
        if (samp) { x0 = p.state_conv[(size_t)(bs * 3 + 0) * 1024 + ch]; x1 = p.state_conv[(size_t)(bs * 3 + 1) * 1024 + ch]; x2 = p.state_conv[(size_t)(bs * 3 + 2) * 1024 + ch]; }
        else if (c == 0) { x0 = 0.f; x1 = 0.f; x2 = 0.f; }
        else { x0 = bf2f(p.XL[(tok0 - 3) * 1024 + ch]); x1 = bf2f(p.XL[(tok0 - 2) * 1024 + ch]); x2 = bf2f(p.XL[(tok0 - 1) * 1024 + ch]); }
        LAS char* raw = scr + 9216;
        { const char* gx = (const char*)(p.XL + tok0 * 1024 + n * 64); const unsigned go = (unsigned)((lane >> 3) * 2048 + (lane & 7) * 16);
          u32x4 v[8];
#pragma unroll
          for (int i = 0; i < 8; ++i) v[i] = *(const u32x4*)(gx + (size_t)i * 8 * 2048 + go);
#pragma unroll
          for (int i = 0; i < 8; ++i) *(LAS u32x4*)(raw + ((lane >> 3) + 8 * i) * 128 + (lane & 7) * 16) = v[i]; }
        LDS_FENCE();
#pragma unroll 16
        for (int t = 0; t < 64; ++t) { const float x3 = bf2f(*(const LAS bf16_t*)(raw + t * 128 + lane * 2)); const float xc = cb + w0 * x0 + w1 * x1 + w2 * x2 + w3 * x3; sx[t * 72 + lane] = f2bf(xc); x0 = x1; x1 = x2; x2 = x3; }
    }
    LDS_FENCE();
    for (int nt = 0; nt < 2; ++nt) {
        const int chd = n * 64 + 32 * nt + l31;
        f32x16 R[2], I[2];
#pragma unroll
        for (int r = 0; r < 16; ++r) { R[0][r] = 0.f; R[1][r] = 0.f; I[0][r] = 0.f; I[1][r] = 0.f; }
#pragma unroll
        for (int kk = 0; kk < 4; ++kk) {
            const bf16x8 br = *(const bf16x8*)(p.WRt + (size_t)chd * 64 + 16 * kk + 8 * hi);
            const bf16x8 bi = *(const bf16x8*)(p.WIt + (size_t)chd * 64 + 16 * kk + 8 * hi);
#pragma unroll
            for (int mt = 0; mt < 2; ++mt) { const bf16x8 a = *(const LAS bf16x8*)(scr + (32 * mt + l31) * 144 + (16 * kk + 8 * hi) * 2); R[mt] = MFMA32(a, br, R[mt]); I[mt] = MFMA32(a, bi, I[mt]); }
        }
        const float brv = p.b_r[chd], biv = p.b_i[chd];
        const float sp8 = -8.0f * log1pf(__expf(-p.lam[chd]));
#pragma unroll
        for (int mt = 0; mt < 2; ++mt)
#pragma unroll
            for (int r = 0; r < 16; ++r) { const int t = 32 * mt + crow(r, hi); const float xcv = bf2f(sx[t * 72 + 32 * nt + l31]);
                const float rg = fsigmoid(R[mt][r] + brv), ig = fsigmoid(I[mt][r] + biv);
                const bf16_t lab = f2bf(rg * sp8); const float la = bf2f(lab), av = __builtin_amdgcn_exp2f(la * 1.4426950408889634f), x2 = 2.0f * la;
                const float ser = -x2 * (1.0f + x2 * (0.5f + x2 * (0.16666667f + x2 * (0.041666668f + x2 * 0.008333334f))));
                const float om = (x2 > -0.25f) ? ser : (1.0f - av * av);
                const bf16_t ub16 = f2bf(__builtin_amdgcn_sqrtf(om) * ig * xcv);
                R[mt][r] = av; I[mt][r] = bf2f(ub16);
                if (!FINAL) { const size_t ub = ((tok0 + 32 * mt + (r & 3) + 8 * (r >> 2)) * 1024 + n * 64 + 32 * nt) * 2;
                    *(bf16_t*)((char*)p.LA + ub + lvoff) = lab; *(bf16_t*)((char*)p.U + ub + lvoff) = ub16; } }
        float oA[8], oH[8], pA[8], pH[8];
#pragma unroll
        for (int gi = 0; gi < 8; ++gi) { float A = 1.f, H = 0.f;
#pragma unroll
            for (int j = 0; j < 4; ++j) { const float a = R[gi >> 2][(gi & 3) * 4 + j]; H = a * H + I[gi >> 2][(gi & 3) * 4 + j]; A *= a; }
            oA[gi] = A; oH[gi] = H; pA[gi] = __shfl_xor(A, 32); pH[gi] = __shfl_xor(H, 32); }
        float h = 0.f;
        if (FINAL) {
            if (samp) h = p.state_lru[(size_t)bs * 1024 + chd];
            else h = p.CARRY[(size_t)tl * 1024 + chd];
        }
        float cin[8], Atot = 1.f;
#pragma unroll
        for (int k = 0; k < 8; ++k) { const float Alo = hi ? pA[k] : oA[k], Hlo = hi ? pH[k] : oH[k], Ahi = hi ? oA[k] : pA[k], Hhi = hi ? oH[k] : pH[k];
            const float hm = Alo * h + Hlo; cin[k] = hi ? hm : h; h = Ahi * hm + Hhi; Atot *= Alo * Ahi; }
        if (!FINAL) { if (hi == 0 && !samp) { p.AGG[(size_t)tl * 2048 + chd] = Atot; p.AGG[(size_t)tl * 2048 + 1024 + chd] = h; } }
        else {
#pragma unroll
            for (int gi = 0; gi < 8; ++gi) { float hh = cin[gi];
#pragma unroll
                for (int j = 0; j < 4; ++j) { const int r = (gi & 3) * 4 + j, mt = gi >> 2; hh = R[mt][r] * hh + I[mt][r]; const size_t ub = ((tok0 + 32 * mt + (r & 3) + 8 * (r >> 2)) * 1024 + n * 64 + 32 * nt) * 2;
                    *(bf16_t*)((char*)p.BO + ub + lvoff) = f2bf(hh * bf2f(*(const bf16_t*)((const char*)p.GG + ub + lvoff))); } }
            if (hi == 0) { if (samp) p.out[O_LS + (size_t)bs * 1024 + chd] = h; else if (c == 127) p.out[O_LP + (size_t)bp * 1024 + chd] = h; }
        }
    }
    LDS_FENCE();
}

__device__ __forceinline__ void lru_final_light(const LruP& p, int tl, int n, int lane) {
    const bool samp = tl >= 512; const int bs = tl - 512, c = tl & 127, bp = tl >> 7; const size_t tok0 = (size_t)tl * 64;
    const int ch = n * 64 + lane; const unsigned l2 = (unsigned)lane * 2u;
    float h = samp ? p.state_lru[(size_t)bs * 1024 + ch] : p.CARRY[(size_t)tl * 1024 + ch];
#pragma unroll 16
    for (int t = 0; t < 64; ++t) { const size_t ub = ((tok0 + t) * 1024 + n * 64) * 2;
        const float la = bf2f(*(const bf16_t*)((const char*)p.LA + ub + l2)), u = bf2f(*(const bf16_t*)((const char*)p.U + ub + l2)), gg = bf2f(*(const bf16_t*)((const char*)p.GG + ub + l2));
        h = __builtin_amdgcn_exp2f(la * 1.4426950408889634f) * h + u;
        *(bf16_t*)((char*)p.BO + ub + l2) = f2bf(h * gg); }
    if (samp) p.out[O_LS + (size_t)bs * 1024 + ch] = h; else if (c == 127) p.out[O_LP + (size_t)bp * 1024 + ch] = h;
}
constexpr int AT_KB = 16384, AT_BUF = 32768, AT_EXCH = 2 * AT_BUF, AT_WSF = AT_EXCH + 65536;
static_assert(AT_WSF + 2048 <= LDS_BYTES, "attention LDS map");
typedef short v4i16_t __attribute__((ext_vector_type(4)));
struct AttP { const bf16_t *Q, *Kb, *VT; bf16_t* AO; const float *cache_k, *cache_v, *head_gain; int flags; };
template <bool SAMPLE>
__device__ __forceinline__ void attn_unit(const AttP& p, LAS char* lds, int b, int h, int qb, float lam) {
    const int tid = threadIdx.x, lane = tid & 63, l31 = lane & 31, hi = lane >> 5;
    const int w = __builtin_amdgcn_readfirstlane(tid >> 6), c = w >> 2, wq = w & 3;
    const size_t tok0 = SAMPLE ? (size_t)(TP + b * 64) : (size_t)b * SEQP;
    const int q0 = SAMPLE ? 0 : qb * 128;
    const int NT = SAMPLE ? 17 : 2 * qb + 2;
    const bool active = SAMPLE ? (wq < 2) : true;
    const int myNT = SAMPLE ? 17 : (wq < 2 ? NT - 1 : NT);
    LAS float* wsf = (LAS float*)(lds + AT_WSF) + w * 64;
    const int kfo = l31 * 256, kfx = (c * 8 + hi) ^ (l31 & 15);
    const int vq = (lane & 15) >> 2, vfo = (4 * hi + vq) * 256 + ((lane >> 4) & 1) * 32 + (lane & 3) * 8;
    const unsigned aovoff = (unsigned)((4 * hi * 1024 + l31) * 2);
    bf16x8 qf[4];
    { const bf16_t* qp = p.Q + (tok0 + q0 + (active ? wq : 0) * 32 + l31) * 1024 + h * 128 + c * 64 + hi * 8;
#pragma unroll
      for (int d0 = 0; d0 < 4; ++d0) qf[d0] = *(const bf16x8*)(qp + d0 * 16); }
    f32x16 O[4];
#pragma unroll
    for (int dt = 0; dt < 4; ++dt)
#pragma unroll
        for (int r = 0; r < 16; ++r) O[dt][r] = 0.f;
    float mrun = 0.f, lrun = 0.f;
    u32x4 st[4];
    if (!SAMPLE) { st[0] = st[1] = st[2] = st[3] = (u32x4){0u, 0u, 0u, 0u}; }
    const unsigned coff_l = (unsigned)(((tid >> 5) * 1024 + (tid & 31) * 4) * 4);
    unsigned ksrc[2], vsrc[2];
#pragma unroll
    for (int i = 0; i < 2; ++i) { const int row = 4 * (w * 2 + i) + (lane >> 4), chp = lane & 15;
        ksrc[i] = (unsigned)((row * 1024 + (chp ^ (row & 15)) * 8) * 2); vsrc[i] = (unsigned)((row * 1024 + (chp ^ ((row & 3) << 2)) * 8) * 2); }
#define DMA_K(trow_, buf_) do { const char* gk_ = (const char*)(p.Kb + (size_t)(trow_) * 1024 + h * 128); _Pragma("unroll") for (int i = 0; i < 2; ++i) \
            __builtin_amdgcn_global_load_lds((const unsigned*)(gk_ + ksrc[i]), (LAS unsigned*)(lds + (buf_) * AT_BUF + (w * 2 + i) * 1024), 16, 0, 0); } while (0)
#define DMA_V(trow_, buf_) do { const char* gv_ = (const char*)(p.VT + (size_t)(trow_) * 1024 + h * 128); _Pragma("unroll") for (int i = 0; i < 2; ++i) \
            __builtin_amdgcn_global_load_lds((const unsigned*)(gv_ + vsrc[i]), (LAS unsigned*)(lds + (buf_) * AT_BUF + AT_KB + (w * 2 + i) * 1024), 16, 0, 0); } while (0)
#define LOAD_F32(src_, t_) do { _Pragma("unroll") for (int i = 0; i < 4; ++i) { \
            st[i] = *(const u32x4*)((const char*)((src_) + (((size_t)b * 1024 + (t_) * 64 + 16 * i) * 8 + h) * 128) + coff_l); } } while (0)
#define STORE_F32(buf_, boff_, isv_) do { LAS char* kb_ = lds + (buf_) * AT_BUF + (boff_); _Pragma("unroll") for (int i = 0; i < 4; ++i) { const int id = tid + 512 * i; const int row = id >> 5, c4 = id & 31; \
            u32x2 kk; kk.x = pk2(__uint_as_float(st[i][0]), __uint_as_float(st[i][1])); kk.y = pk2(__uint_as_float(st[i][2]), __uint_as_float(st[i][3])); \
            const int sw_ = (isv_) ? ((row & 3) << 2) : (row & 15); \
            *(LAS u32x2*)(kb_ + row * 256 + (((c4 >> 1) ^ sw_) << 4) + (c4 & 1) * 8) = kk; } } while (0)
    if (SAMPLE) { LOAD_F32(p.cache_k, 0); STORE_F32(0, 0, 0); } else { DMA_K(tok0, 0); }
    __syncthreads();
    mrun = 0.f;
    bf16x8 pa0, pa1, pa2, pa3;
    pa0 = pa1 = pa2 = pa3 = (bf16x8){0, 0, 0, 0, 0, 0, 0, 0};
#define VLOAD(dst_, s_) do { _Pragma("unroll") for (int dt = 0; dt < 4; ++dt) { LAS char* vp = vb + vfo + ((dt ^ vq) << 6) + (16 * (s_)) * 256; \
                    const v4i16_t lo_ = __builtin_amdgcn_ds_read_tr16_b64_v4i16((LAS v4i16_t*)vp), hh_ = __builtin_amdgcn_ds_read_tr16_b64_v4i16((LAS v4i16_t*)(vp + 8 * 256)); \
                    dst_[dt] = __builtin_shufflevector(lo_, hh_, 0, 1, 2, 3, 4, 5, 6, 7); } } while (0)
#define PKP(P_, q_) __builtin_bit_cast(bf16x8, (u32x4){pk2(P_[8 * q_ + 0], P_[8 * q_ + 1]), pk2(P_[8 * q_ + 2], P_[8 * q_ + 3]), pk2(P_[8 * q_ + 4], P_[8 * q_ + 5]), pk2(P_[8 * q_ + 6], P_[8 * q_ + 7])})
#define PVMM(pa_, vf_) do { _Pragma("unroll") for (int dt = 0; dt < 4; ++dt) O[dt] = MFMA32(pa_, vf_[dt], O[dt]); } while (0)
#define PV_ALL() do { bf16x8 va[4]; VLOAD(va, 0); PVMM(pa0, va); VLOAD(va, 1); PVMM(pa1, va); VLOAD(va, 2); PVMM(pa2, va); VLOAD(va, 3); PVMM(pa3, va); } while (0)
#define QK_MAX(t_, kb_) \
            const bool maskt = !SAMPLE && ((t_) >= myNT);        \
            f32x16 p0, p1; \
            _Pragma("unroll") for (int r = 0; r < 16; ++r) { p0[r] = 0.f; p1[r] = 0.f; } \
            _Pragma("unroll") for (int d0 = 0; d0 < 4; ++d0) { \
                const bf16x8 k0 = *(const LAS bf16x8*)((kb_) + kfo + ((kfx ^ (d0 << 1)) << 4)); \
                const bf16x8 k1 = *(const LAS bf16x8*)((kb_) + kfo + 8192 + ((kfx ^ (d0 << 1)) << 4)); \
                p0 = MFMA32(k0, qf[d0], p0); p1 = MFMA32(k1, qf[d0], p1); } \
            __builtin_amdgcn_sched_group_barrier(0x100, 4, 0); \
            _Pragma("unroll") for (int i_ = 0; i_ < 2; ++i_) { __builtin_amdgcn_sched_group_barrier(0x008, 1, 0); __builtin_amdgcn_sched_group_barrier(0x100, 2, 0); } \
            __builtin_amdgcn_sched_group_barrier(0x008, 6, 0); \
            float rm = fmaxf(fmaxf(p0[0], p1[0]), p0[1]); \
            _Pragma("unroll") for (int r = 2; r < 16; r += 2) rm = fmaxf(fmaxf(rm, p0[r]), p0[r + 1]); \
            _Pragma("unroll") for (int r = 1; r < 16; r += 2) rm = fmaxf(fmaxf(rm, p1[r]), p1[(r + 1) & 15]); \
            rm = fmaxf(rm, __shfl_xor(rm, 32)) - mrun; \
            if (maskt) rm = 0.f; \
            const bool resc = __any(rm > 8.0f) || (t_) == 0;     \
            float alpha = 1.0f; \
            if (resc) { const float dl = (rm > 8.0f || (t_) == 0) ? rm : 0.f; alpha = __builtin_amdgcn_exp2f(-dl); mrun += dl; lrun *= alpha; } \
            const float sh = maskt ? 1e30f : mrun; \
            _Pragma("unroll") for (int r = 0; r < 16; ++r) { p0[r] -= sh; p1[r] -= sh; } \
            __builtin_amdgcn_sched_barrier(0);
#define O_RESCALE() do { if (resc) { if (hi == 0) wsf[l31] = alpha; LDS_FENCE(); \
                _Pragma("unroll") for (int r = 0; r < 16; ++r) { const float a_ = wsf[crow(r, hi)]; _Pragma("unroll") for (int dt = 0; dt < 4; ++dt) O[dt][r] *= a_; } LDS_FENCE(); } } while (0)
    if (!SAMPLE) { DMA_K(tok0 + 64, 1); DMA_V(tok0, 0); }
    if (active) {
        QK_MAX(0, lds)
        float ls = 0.f;
#pragma unroll
        for (int r = 0; r < 16; ++r) { p0[r] = __builtin_amdgcn_exp2f(p0[r]); p1[r] = __builtin_amdgcn_exp2f(p1[r]); ls += p0[r] + p1[r]; }
        lrun += ls;
        pa0 = PKP(p0, 0); pa1 = PKP(p0, 1); pa2 = PKP(p1, 0); pa3 = PKP(p1, 1);
    }
    if (SAMPLE) { LOAD_F32(p.cache_k, 1); STORE_F32(1, 0, 0); LOAD_F32(p.cache_v, 0); STORE_F32(0, AT_KB, 1); }
    __syncthreads();
    for (int t = 1; t < NT; ++t) {
        const int buf = t & 1;
        if (!SAMPLE) { if (t + 1 < NT) DMA_K(tok0 + (size_t)(t + 1) * 64, buf ^ 1); DMA_V(tok0 + (size_t)t * 64, buf); }
        else { if (t + 1 == 16) DMA_K(tok0, buf ^ 1); if (t == 16) DMA_V(tok0, buf); }
        LAS char* vb = lds + (buf ^ 1) * AT_BUF + AT_KB;
        if (active) {
            QK_MAX(t, lds + buf * AT_BUF)
            float ls = 0.f;
            bf16x8 va[4];
#define EXP8(P_, q_) do { _Pragma("unroll") for (int r = 8 * (q_); r < 8 * (q_) + 8; ++r) { P_[r] = __builtin_amdgcn_exp2f(P_[r]); ls += P_[r]; } } while (0)
            VLOAD(va, 0); EXP8(p0, 0); PVMM(pa0, va); pa0 = PKP(p0, 0);
            VLOAD(va, 1); EXP8(p0, 1); PVMM(pa1, va); pa1 = PKP(p0, 1);
            VLOAD(va, 2); EXP8(p1, 0); PVMM(pa2, va); pa2 = PKP(p1, 0);
            VLOAD(va, 3); EXP8(p1, 1); PVMM(pa3, va); pa3 = PKP(p1, 1);
#undef EXP8
            __builtin_amdgcn_sched_group_barrier(0x100, 8, 0); __builtin_amdgcn_sched_group_barrier(0x002, 8, 0);
#pragma unroll
            for (int i_ = 0; i_ < 8; ++i_) { __builtin_amdgcn_sched_group_barrier(0x008, 1, 0); __builtin_amdgcn_sched_group_barrier(0x100, 2, 0); __builtin_amdgcn_sched_group_barrier(0x002, 5, 0); }
#pragma unroll
            for (int i_ = 0; i_ < 4; ++i_) { __builtin_amdgcn_sched_group_barrier(0x008, 1, 0); __builtin_amdgcn_sched_group_barrier(0x100, 2, 0); __builtin_amdgcn_sched_group_barrier(0x002, 4, 0); }
#pragma unroll
            for (int i_ = 0; i_ < 4; ++i_) { __builtin_amdgcn_sched_group_barrier(0x008, 1, 0); __builtin_amdgcn_sched_group_barrier(0x002, 4, 0); }
            lrun += ls;
            O_RESCALE();
        }
        if (SAMPLE) { if (t + 1 < 16) { LOAD_F32(p.cache_k, t + 1); STORE_F32(buf ^ 1, 0, 0); } if (t < 16) { LOAD_F32(p.cache_v, t); STORE_F32(buf, AT_KB, 1); } }
        __syncthreads();
    }
    if (active) { LAS char* vb = lds + ((NT - 1) & 1) * AT_BUF + AT_KB; PV_ALL(); }
    __syncthreads();
#undef QK_MAX
#undef O_RESCALE
#undef VLOAD
#undef PKP
#undef PVMM
#undef PV_ALL
    if (active) {
        const float lt = lrun + __shfl_xor(lrun, 32);
        const float sc = (c == 0 ? 1.0f : lam) * __builtin_amdgcn_rcpf(lt);
        if (hi == 0) wsf[l31] = sc;
        LDS_FENCE();
#pragma unroll
        for (int r = 0; r < 16; ++r) { const float a = wsf[crow(r, hi)];
#pragma unroll
            for (int dt = 0; dt < 4; ++dt) O[dt][r] *= a; }
        LDS_FENCE();
    }
    LAS float* ex = (LAS float*)(lds + AT_EXCH) + wq * 4096;
    if (active && c == 1) {
#pragma unroll
        for (int dt = 0; dt < 4; ++dt)
#pragma unroll
            for (int r = 0; r < 16; ++r) ex[(dt * 16 + r) * 64 + lane] = O[dt][r];
    }
    __syncthreads();
    if (active && c == 0) {
        float hg[4];
#pragma unroll
        for (int dt = 0; dt < 4; ++dt) hg[dt] = p.head_gain[32 * dt + l31] * 0.8f;
#pragma unroll
        for (int r = 0; r < 16; ++r) {
            float o[4], ss = 0.f;
#pragma unroll
            for (int dt = 0; dt < 4; ++dt) { o[dt] = O[dt][r] - ex[(dt * 16 + r) * 64 + lane]; ss += o[dt] * o[dt]; }
            ss += __shfl_xor(ss, 1); ss += __shfl_xor(ss, 2); ss += __shfl_xor(ss, 4); ss += __shfl_xor(ss, 8); ss += __shfl_xor(ss, 16);
            const float rs = __builtin_amdgcn_rsqf(ss * (1.0f / 128.0f) + EPS);
            char* op = (char*)(p.AO + (tok0 + q0 + wq * 32 + (r & 3) + 8 * (r >> 2)) * 1024 + h * 128);
#pragma unroll
            for (int dt = 0; dt < 4; ++dt) *(bf16_t*)(op + 64 * dt + aovoff) = f2bf(o[dt] * rs * hg[dt]);
        }
    }
    __syncthreads();
}

#define XB_TMO      128
#define XB_XCNT(j)  (256  + 64 * (j))
#define XB_XSUB(j)  (1280 + 64 * (j))
#define XB_XGEN(j)  (2304 + 64 * (j))
#define XB_TOP      3328
#define XB_TOPGEN   3392
#define XCD_BAR_WORDS 3456
#define XB_SPIN_CAP (1u << 18)

__device__ __forceinline__ unsigned xb_ld(unsigned* p)              { return __hip_atomic_load(p, __ATOMIC_RELAXED, __HIP_MEMORY_SCOPE_AGENT); }
__device__ __forceinline__ unsigned xb_add(unsigned* p, unsigned v) { return __hip_atomic_fetch_add(p, v, __ATOMIC_RELAXED, __HIP_MEMORY_SCOPE_AGENT); }
__device__ __forceinline__ unsigned xb_xcc_id() { return (unsigned)__builtin_amdgcn_s_getreg((3 << 11) | 20) & 0xFu; }
#define XB_SPIN(cond, bar) do { unsigned _sp = 0; while (cond) { __builtin_amdgcn_s_sleep(1); \
    if ((++_sp & 255u) == 0u) { if (xb_ld(&(bar)[XB_TMO])) break; if (_sp > XB_SPIN_CAP) { atomicAdd(&(bar)[XB_TMO], 1u); break; } } } } while (0)

struct XcdBarrier {
    unsigned* bar; unsigned x;
    volatile LAS unsigned* st;
};

__device__ __forceinline__ XcdBarrier xcd_barrier_post(unsigned* bar, volatile LAS unsigned* st) {
    XcdBarrier b; b.bar = bar; b.x = xb_xcc_id(); b.st = st;
    if (threadIdx.x == 0) (void)xb_add(&bar[XB_XCNT(b.x)], 1u);
    return b;
}
__device__ __forceinline__ void xcd_barrier_complete(unsigned* bar, unsigned x, unsigned& nloc, unsigned& nx) {
    const unsigned G = gridDim.x * gridDim.y * gridDim.z;
    unsigned sum, cnt, mine, sp = 0u;
    for (;;) {
        sum = 0u; cnt = 0u; mine = 0u;
#pragma unroll
        for (unsigned j = 0; j < 16; ++j) { const unsigned c = xb_ld(&bar[XB_XCNT(j)]); sum += c; cnt += (c > 0u) ? 1u : 0u; mine = (j == x) ? c : mine; }
        if (sum == G) break;
        __builtin_amdgcn_s_sleep(1);
        if ((++sp & 255u) == 0u) { if (xb_ld(&bar[XB_TMO])) break; if (sp > XB_SPIN_CAP) { atomicAdd(&bar[XB_TMO], 1u); break; } }
    }
    nloc = mine > 0u ? mine : 1u; nx = cnt > 0u ? cnt : 1u;
}

__device__ __forceinline__ void xcd_barrier(const XcdBarrier& b) {
    asm volatile("s_waitcnt vmcnt(0)" ::: "memory");
    __syncthreads();
    if (threadIdx.x == 0) {
        unsigned* bar = b.bar;
        __builtin_amdgcn_s_waitcnt(0);
        unsigned nloc = b.st[0], nx = b.st[1];
        if (nloc == 0u) { xcd_barrier_complete(bar, b.x, nloc, nx); b.st[0] = nloc; b.st[1] = nx; }
        const unsigned old = xb_add(&bar[XB_XSUB(b.x)], 1u);
        const unsigned gen = old / nloc;
        if (old + 1u == (gen + 1u) * nloc) {
            __builtin_amdgcn_fence(__ATOMIC_RELEASE, "agent");
            asm volatile("s_waitcnt vmcnt(0)" ::: "memory");
            const unsigned og = xb_add(&bar[XB_TOP], 1u);
            const unsigned tg = og / nx;
            if (og + 1u == (tg + 1u) * nx) xb_add(&bar[XB_TOPGEN], 1u);
            else XB_SPIN(xb_ld(&bar[XB_TOPGEN]) == tg, bar);
            __builtin_amdgcn_fence(__ATOMIC_ACQUIRE, "agent");
            xb_add(&bar[XB_XGEN(b.x)], 1u);
            asm volatile("s_waitcnt vmcnt(0)" ::: "memory");
        } else {
            XB_SPIN(xb_ld(&bar[XB_XGEN(b.x)]) == gen, bar);
            __builtin_amdgcn_fence(__ATOMIC_ACQUIRE, "agent");
            asm volatile("s_waitcnt vmcnt(0)" ::: "memory");
        }
    }
    __syncthreads();
}


__device__ __forceinline__ void grid_bar(unsigned* cnt, unsigned target) {
    asm volatile("s_waitcnt vmcnt(0)" ::: "memory");
    __syncthreads();
    if (threadIdx.x == 0) {
        __builtin_amdgcn_fence(__ATOMIC_RELEASE, "agent");
        asm volatile("s_waitcnt vmcnt(0)" ::: "memory");
        __hip_atomic_fetch_add(cnt, 1u, __ATOMIC_RELAXED, __HIP_MEMORY_SCOPE_AGENT);
        while (__hip_atomic_load(cnt, __ATOMIC_RELAXED, __HIP_MEMORY_SCOPE_AGENT) < target) __builtin_amdgcn_s_sleep(2);
        __builtin_amdgcn_fence(__ATOMIC_ACQUIRE, "agent");
        asm volatile("s_waitcnt vmcnt(0)" ::: "memory");
    }
    __syncthreads();
}
__global__ void __launch_bounds__(512, 2) mega(Args a) {
    extern __shared__ __attribute__((aligned(16))) unsigned char lds_raw[];
    LAS unsigned char* lds = (LAS unsigned char*)lds_raw;
    const int tid = threadIdx.x, lane = tid & 63, wave = __builtin_amdgcn_readfirstlane(tid >> 6);
    const int G = gridDim.x, bx = blockIdx.x;
    const int vcu = (G % 8 == 0) ? (bx % 8) * (G / 8) + bx / 8 : bx;
    const int gw = vcu * 8 + wave, NGW = G * 8;
    unsigned char* ws = a.ws;
    bf16_t* WinT = (bf16_t*)(ws + WS_WIN); bf16_t* WbaT = (bf16_t*)(ws + WS_WBA); bf16_t* WblT = (bf16_t*)(ws + WS_WBL); bf16_t* WoT = (bf16_t*)(ws + WS_WO);
    bf16_t* WupT = (bf16_t*)(ws + WS_WUP); bf16_t* WdnT = (bf16_t*)(ws + WS_WDN); bf16_t* WRt = (bf16_t*)(ws + WS_WR); bf16_t* WIt = (bf16_t*)(ws + WS_WI);
    float* AGG = (float*)(ws + WS_AGG); float* RSS = (float*)(ws + WS_RSS);
    bf16_t* S0 = (bf16_t*)(ws + WS_SLOT0); bf16_t* S1 = (bf16_t*)(ws + WS_SLOT0 + SLOT); bf16_t* S2 = (bf16_t*)(ws + WS_SLOT0 + 2 * SLOT); bf16_t* S3 = (bf16_t*)(ws + WS_SLOT0 + 3 * SLOT);
    bf16_t* S4 = (bf16_t*)(ws + WS_SLOT0 + 4 * SLOT); bf16_t* S5 = (bf16_t*)(ws + WS_SLOT0 + 5 * SLOT);
    bf16_t *XN = S0, *BO = S0, *Qb = S1, *AO = S1, *Kb = S2, *MG = S2, *VT = S3, *TMP = S4, *XL = S4, *GG = S5, *HB = S5, *UP = S0;
    bf16_t* GA = (bf16_t*)(a.out + O_Y); bf16_t* GB = GA + (size_t)T * 1024;
    float* H = a.out + O_Y;
    const int lo = a.ph_lo, hi_ph = a.ph_hi;
#ifdef ONLYPH
#define IN(k) ((k) == ONLYPH && lo <= (k) && (k) < hi_ph)
#else
#define IN(k) (lo <= (k) && (k) < hi_ph)
#endif
    unsigned* barcnt = (unsigned*)(ws + WS_CTL);
    volatile LAS unsigned* xst = (volatile LAS unsigned*)(lds + LDS_BYTES - 16);
    if (tid < 2) xst[tid] = 0u;
    __syncthreads();
    const XcdBarrier xbar = xcd_barrier_post((unsigned*)(ws + WS_XB), xst);
    if (a.ph_lo < 0) cg::this_grid().sync();
#define SYNC(k) do { if (IN(k) && IN((k) + 1)) xcd_barrier(xbar); } while (0)

    if (IN(0)) for (int rep = 0; rep < REPN(0); ++rep) {
        LAS float* scr = (LAS float*)(lds + wave * 16384);
        constexpr int I_IN = 16 * 224, I_SQ = 16 * 32, I_UP = 16 * 128, I_DN = 64 * 32, I_G = 32;
        constexpr int NIT = I_IN + 3 * I_SQ + 2 * I_G;
        for (int it = gw; it < NIT; it += NGW) {
            int r = it;
            if (r < I_IN) { transpose_item(a.w_in, 1024, NIN, nullptr, WinT, scr, r, lane); continue; } r -= I_IN;
            if (r < I_SQ) { transpose_item(a.w_ba, 1024, 1024, nullptr, WbaT, scr, r, lane); continue; } r -= I_SQ;
            if (r < I_SQ) { transpose_item(a.w_bl, 1024, 1024, nullptr, WblT, scr, r, lane); continue; } r -= I_SQ;
            if (r < I_SQ) { transpose_item(a.w_o, 1024, 1024, nullptr, WoT, scr, r, lane); continue; } r -= I_SQ;
            if (r < I_G) { transpose_item(a.w_rgate + (size_t)(r >> 1) * 4096, 64, 64, nullptr, WRt + (size_t)(r >> 1) * 4096, scr, r & 1, lane); continue; } r -= I_G;
            transpose_item(a.w_igate + (size_t)(r >> 1) * 4096, 64, 64, nullptr, WIt + (size_t)(r >> 1) * 4096, scr, r & 1, lane);
        }
        f32x4 g[4];
#pragma unroll
        for (int j = 0; j < 4; ++j) g[j] = ((const f32x4*)a.norm_mix)[lane + 64 * j];
        for (int m = gw; m < T; m += NGW) {
            const float* xr = (m < TP) ? a.x_prompt + (size_t)m * 1024 : a.x_sample + (size_t)(m - TP) * 1024;
            f32x4 v[4]; float s = 0.f;
#pragma unroll
            for (int j = 0; j < 4; ++j) { v[j] = ((const f32x4*)xr)[lane + 64 * j]; s += (v[j][0] * v[j][0] + v[j][1] * v[j][1]) + (v[j][2] * v[j][2] + v[j][3] * v[j][3]); }
            const float rstd = 1.0f / sqrtf(wave_sum(s) * (1.0f / 1024.0f) + EPS);
            u32x2* o = (u32x2*)(XN + (size_t)m * 1024);
#pragma unroll
            for (int j = 0; j < 4; ++j) { u32x2 w2; w2.x = pk2(v[j][0] * rstd * g[j][0], v[j][1] * rstd * g[j][1]); w2.y = pk2(v[j][2] * rstd * g[j][2], v[j][3] * rstd * g[j][3]); o[lane + 64 * j] = w2; }
        }
    }
    SYNC(0);
    if (IN(1)) for (int rep = 0; rep < REPN(1); ++rep) {
        pg8::Gemm g{XN, WinT, T, NIN, 1024, 1024}; pg8::StaticOrder S; S.init(T, NIN, G, bx);
        EpiIn E{Qb, Kb, VT, XL, GG, GA, GB, a.out};
        pg8::gemm_phase<EpiIn, pg8::StaticOrder, true, true>(lds, g, S, E);
    }
    SYNC(1);
    float* CARRY = (float*)(ws + WS_CARRY);
    LruP lp{XL, GG, WRt, WIt, BO, S2, S3, AGG, CARRY, a.conv_w, a.conv_b, a.b_rgate, a.b_igate, a.lru_lambda, a.state_conv, a.state_lru, a.out};
    if (IN(2)) {
        float lam;
        { const float q0 = a.lambda_q[lane], k0 = a.lambda_k[lane], q1 = a.lambda_q[64 + lane], k1 = a.lambda_k[64 + lane];
          lam = __expf(wave_sum(q0 * k0)) - __expf(wave_sum(q1 * k1)) + 0.2f; }
        AttP ap{Qb, Kb, VT, AO, a.cache_k, a.cache_v, a.head_gain, a.flags};
        { const int nsamp = (vcu < 256) ? (255 - vcu) / G + 1 : 0, npr = (vcu < 1024) ? 2 * ((1023 - vcu) / G + 1) : 0;
          const int ss = nsamp ? (vcu % (npr + 1)) : -1;
          int si = 0, pi = 0;
          for (int k = 0; k < npr + nsamp; ++k) {
              const bool is_s = (si < nsamp) && (k == ss || pi >= npr);
              if (is_s) { const int u = vcu + si * G; attn_unit<true>(ap, (LAS char*)lds, u >> 3, u & 7, 0, lam); ++si; }
              else { const int pr = vcu + (pi >> 1) * G, bh = pr >> 5, s = pr & 31; attn_unit<false>(ap, (LAS char*)lds, bh >> 3, bh & 7, (pi & 1) ? s : 63 - s, lam); ++pi; } } }
    }
    SYNC(2);
    if (IN(3)) {
        LAS char* scr = (LAS char*)lds + wave * 17408;
        for (int it = gw; it < 544 * 16; it += NGW) lru_item<false>(lp, scr, it >> 4, it & 15, lane);
    }
    SYNC(3);
    if (IN(4)) {
        if (vcu >= 4 && vcu < 12) {
            const int gt = (vcu - 4) * 512 + tid; const int b = gt >> 10, ch = gt & 1023; const float* ag = AGG + (size_t)(b * 128) * 2048 + ch; float* cr = CARRY + (size_t)(b * 128) * 1024 + ch; float h = 0.f;
#pragma unroll 16
            for (int j = 0; j < 128; ++j) { cr[(size_t)j * 1024] = h; h = ag[(size_t)j * 2048] * h + ag[(size_t)j * 2048 + 1024]; }
            asm volatile("s_waitcnt vmcnt(0)" ::: "memory"); __syncthreads();
            if (tid == 0) { __builtin_amdgcn_fence(__ATOMIC_RELEASE, "agent"); asm volatile("s_waitcnt vmcnt(0)" ::: "memory"); __hip_atomic_fetch_add(barcnt + 32, 1u, __ATOMIC_RELAXED, __HIP_MEMORY_SCOPE_AGENT); }
        }
        { pg8::Gemm g{AO, WbaT, T, 1024, 1024, 1024}; pg8::StaticOrder S; S.init(T, 1024, G, bx); EpiM1 E{GA, TMP};
          pg8::gemm_phase<EpiM1, pg8::StaticOrder, true, true>(lds, g, S, E); }
        while (__builtin_amdgcn_readfirstlane((int)__hip_atomic_load(barcnt + 32, __ATOMIC_RELAXED, __HIP_MEMORY_SCOPE_AGENT)) < (G < 8 ? G : 8)) __builtin_amdgcn_s_sleep(2);
        __builtin_amdgcn_fence(__ATOMIC_ACQUIRE, "agent"); asm volatile("s_waitcnt vmcnt(0)" ::: "memory");
        for (int it = gw; it < 544 * 16; it += NGW) lru_final_light(lp, it >> 4, it & 15, lane);
    }
    SYNC(4);
    if (IN(5)) for (int rep = 0; rep < REPN(5); ++rep) {
        { pg8::Gemm g{BO, WblT, T, 1024, 1024, 1024}; pg8::StaticOrder S; S.init(T, 1024, G, bx); EpiM2 E{GB, TMP, MG};
          pg8::gemm_phase<EpiM2, pg8::StaticOrder, true, true>(lds, g, S, E); }
        { const int nheavy = (544 - 2 * G > 0 && 544 - 2 * G < G) ? 544 - 2 * G : 0, nlw = (G - nheavy) * 8;
          if (bx >= nheavy) { __syncthreads(); LAS float* scr = (LAS float*)(lds + wave * 16384);
              for (int r = (bx - nheavy) * 8 + wave; r < 16 * 128 + 64 * 32; r += nlw) {
                  if (r < 16 * 128) transpose_item(a.w_up, 1024, FF, a.norm_mlp, WupT, scr, r, lane); else transpose_item(a.w_down, FF, 1024, nullptr, WdnT, scr, r - 16 * 128, lane); } } }
    }
    SYNC(5);
    if (IN(6)) for (int rep = 0; rep < REPN(6); ++rep) {
        pg8::Gemm g{MG, WoT, T, 1024, 1024, 1024}; pg8::StaticOrder S; S.init(T, 1024, G, bx); EpiO E{a.x_prompt, a.x_sample, H, HB, RSS};
        pg8::gemm_phase<EpiO, pg8::StaticOrder, true, true>(lds, g, S, E);
    }
    SYNC(6);
    if (IN(7)) for (int rep = 0; rep < REPN(7); ++rep) {
        pg8::Gemm g{HB, WupT, T, FF, 1024, 1024}; pg8::StaticOrder S; S.init(T, FF, G, bx); EpiUp E{RSS, UP};
        pg8::gemm_phase<EpiUp, pg8::StaticOrder, true, true>(lds, g, S, E);
    }
    SYNC(7);
    if (IN(8)) {
        { pg8::Gemm g{UP, WdnT, TP, 1024, FF, FF}; pg8::StaticOrder S; S.init(TP, 1024, G, bx); EpiDown E{H};
          pg8::gemm_phase<EpiDown, pg8::StaticOrder, true, true>(lds, g, S, E); }
        { pg8::Gemm g{UP, WdnT, T, 1024, 512, FF}; SplitOrder S{G, bx}; EpiPart E{(float*)S4};
          pg8::gemm_phase<EpiPart, SplitOrder, true, true>(lds, g, S, E); }
    }
    SYNC(8);
    if (IN(9)) {
        f32x4 g[4];
#pragma unroll
        for (int j = 0; j < 4; ++j) g[j] = ((const f32x4*)a.norm_final)[lane + 64 * j];
        for (int m = gw; m < T; m += NGW) {
            f32x4* xr = (f32x4*)(H + (size_t)m * 1024);
            f32x4 v[4]; float s = 0.f;
#pragma unroll
            for (int j = 0; j < 4; ++j) v[j] = xr[lane + 64 * j];
            if (m >= TP) {
                const f32x4* pp = (const f32x4*)((const float*)S4 + (size_t)(m - TP) * 1024) + lane;
#pragma unroll
                for (int kc = 0; kc < 8; ++kc)
#pragma unroll
                    for (int j = 0; j < 4; ++j) v[j] += pp[(size_t)kc * 2048 * 256 + 64 * j];
            }
#pragma unroll
            for (int j = 0; j < 4; ++j) s += (v[j][0] * v[j][0] + v[j][1] * v[j][1]) + (v[j][2] * v[j][2] + v[j][3] * v[j][3]);
            const float rstd = 1.0f / sqrtf(wave_sum(s) * (1.0f / 1024.0f) + EPS);
#pragma unroll
            for (int j = 0; j < 4; ++j) xr[lane + 64 * j] = v[j] * rstd * g[j];
        }
    }
#undef IN
#undef SYNC
}

constexpr int NPH = 10;
#ifndef MK_LAUNCHES
#define MK_LAUNCHES 1
#endif
extern "C" void kernel_launch(void* const* d_in, const int* in_sizes, int n_in, void* d_out, int out_size, void* d_ws, size_t ws_size, hipStream_t stream) {
    static int grid = 0;
    if (grid == 0) {
        if (n_in != 25 || ws_size < WS_END) { fprintf(stderr, "kernel_launch: unexpected n_in %d / ws %zu (need %zu)\n", n_in, ws_size, (size_t)WS_END); grid = -1; return; }
        int dev = 0, cus = 0, per_cu = 0;
        hipGetDevice(&dev); hipDeviceGetAttribute(&cus, hipDeviceAttributeMultiprocessorCount, dev);
        if (hipFuncSetAttribute((const void*)mega, hipFuncAttributeMaxDynamicSharedMemorySize, LDS_BYTES) != hipSuccess) { fprintf(stderr, "hipFuncSetAttribute failed\n"); grid = -1; return; }
        hipOccupancyMaxActiveBlocksPerMultiprocessor(&per_cu, (const void*)mega, 512, LDS_BYTES);
        if (per_cu < 1) { fprintf(stderr, "occupancy query says %d\n", per_cu); per_cu = 1; }
        (void)hipGetLastError();
        grid = cus * 1;
    }
    if (grid < 0) return;
    if (hipMemsetAsync((char*)d_ws + WS_CTL, 0, 256, stream) != hipSuccess) { fprintf(stderr, "memset failed\n"); return; }
    if (hipMemsetAsync((char*)d_ws + WS_XB, 0, 16384, stream) != hipSuccess) { fprintf(stderr, "memset failed\n"); return; }
    Args a{};
    const float** pf = (const float**)&a;
    for (int i = 0; i < 25; ++i) pf[i] = (const float*)d_in[i];
    a.out = (float*)d_out; a.ws = (unsigned char*)d_ws;
#if MK_LAUNCHES == 1
#ifdef PROBE_PREFIX
    { a.ph_lo = 0; a.ph_hi = PROBE_PREFIX; a.flags = PROBE_FLAGS; void* args0[] = {&a};
      if (hipLaunchCooperativeKernel((const void*)mega, dim3(grid), dim3(512), args0, LDS_BYTES, stream) != hipSuccess) fprintf(stderr, "probe launch failed\n");
      if (hipMemsetAsync((char*)d_ws + WS_CTL, 0, 256, stream) != hipSuccess) fprintf(stderr, "memset failed\n"); }
#endif
    a.ph_lo = 0; a.ph_hi = NPH; a.flags = 0;
    void* args[] = {&a};
    hipError_t e = hipLaunchCooperativeKernel((const void*)mega, dim3(grid), dim3(512), args, LDS_BYTES, stream);
    if (e != hipSuccess) fprintf(stderr, "cooperative launch failed: %s (grid %d)\n", hipGetErrorString(e), grid);
#else
    for (int k = 0; k < NPH; ++k) { a.ph_lo = k; a.ph_hi = k + 1; hipLaunchKernelGGL(mega, dim3(grid), dim3(512), LDS_BYTES, stream, a); }
#endif
}
```

```cpp
#include <hip/hip_runtime.h>
#include <hip/hip_cooperative_groups.h>
#include <cstdio>
#include <cstdint>
namespace cg = cooperative_groups;
namespace pg8 {
#define PG8_LAS __attribute__((address_space(3)))
typedef unsigned short bf16_t;
typedef short bf16x8 __attribute__((ext_vector_type(8)));
typedef float f32x4 __attribute__((ext_vector_type(4)));
typedef unsigned u32x4 __attribute__((ext_vector_type(4)));
constexpr int BM = 256, BK = 64, HALF = 128, HTB = HALF * BK * 2  , STAGE_BYTES = 8 * HTB, NXCD = 8, WGM = 4;

__host__ __device__ __forceinline__ int lds_byte(int r, int c) { const int st = (r >> 4) * 2 + (c >> 5), rr = r & 15, cc = c & 31, ob = rr * 64 + cc * 2; return st * 1024 + (ob ^ (((ob >> 9) & 1) << 5)); }
__host__ __device__ __forceinline__ void stage_rc(int b, int& R, int& C) { const int st = b / 1024, sb = b % 1024, swz = sb ^ (((sb >> 9) & 1) << 5); R = (st >> 1) * 16 + swz / 64; C = (st & 1) * 32 + (swz % 64) / 2; }
__host__ __device__ __forceinline__ int perm32(int rho) { const int n = rho >> 4, i = rho & 15; return 8 * (i >> 2) + 4 * n + (i & 3); }

struct Unit { int pm, pn, kc; };
struct Gemm { const bf16_t* A; const bf16_t* Bt; int M, N, K, ld; };

struct StaticOrder {
    int nM, nN, nwg, G, c;
    __host__ __device__ void init(int M, int N, int G_, int c_) { nM = M / BM; nN = N / BM; nwg = nM * nN; G = G_; c = c_; }
    __host__ __device__ bool next(int i, Unit& u) const {
        const long L = (long)i * G + c; if (L >= nwg) return false;
        int wgid = (int)L; { const int q = nwg / NXCD, r = nwg % NXCD, xcd = wgid % NXCD, off = wgid / NXCD; wgid = (xcd < r ? xcd * (q + 1) : r * (q + 1) + (xcd - r) * q) + off; }
        const int nig = WGM * nN, gid = wgid / nig, fm = gid * WGM, gsz = (nM - fm) < WGM ? (nM - fm) : WGM;
        u.pm = fm + ((wgid % nig) % gsz); u.pn = (wgid % nig) / gsz; u.kc = 0; return true;
    }
    __device__ __forceinline__ void a_ready(const Unit&) const {}
    __device__ __forceinline__ void done(const Unit&) const {}
};

template <class Epi, class Sched, bool ALIGN_EPI = false, bool SP2 = false>
__device__ __forceinline__ void gemm_phase(PG8_LAS unsigned char* lds, const Gemm g, const Sched& S, const Epi& E) {
    const int tid = threadIdx.x, wid = __builtin_amdgcn_readfirstlane(tid >> 6), lane = tid & 63, wr = wid >> 2, wc = wid & 3, fr = lane & 15, fq = lane >> 4;
    const int K = g.ld, nt = g.K / BK; const size_t kcb = (size_t)g.K * 2;
    unsigned voffA[2], voffB[2];
#pragma unroll
    for (int i = 0; i < 2; ++i) { int R, C; stage_rc(tid * 16 + i * 8192, R, C); const int Rb = Epi::PERM ? ((R & ~31) + perm32(R & 31)) : R;
        voffA[i] = (unsigned)(R * K + C) * 2u; voffB[i] = (unsigned)(Rb * K + C) * 2u; }
    const size_t kstep = (size_t)(BK * 2);
    const size_t hstep = (size_t)HALF * K * 2;
    const size_t tstep = 2 * hstep;
    const unsigned ldsw = (unsigned)wid * 1024u;
    const int aoff = lds_byte(wr * 64 + fr, fq * 8), boff = lds_byte(wc * 32 + fr, fq * 8);
#define PG8_SA(b, h) (((b) * 2 + (h)) * HTB)
#define PG8_SB(b, h) ((4 + (b) * 2 + (h)) * HTB)
#define PG8_STAGE(bufoff, gbase, voff) do { _Pragma("unroll") for (int _i = 0; _i < 2; ++_i) \
        __builtin_amdgcn_global_load_lds((const unsigned*)((const char*)(gbase) + (voff)[_i]), (PG8_LAS unsigned*)(lds + (bufoff) + ldsw + _i * 8192), 16, 0, 0); } while (0)
#define PG8_LDA(dst, b, h) do { _Pragma("unroll") for (int m = 0; m < 4; ++m) _Pragma("unroll") for (int k = 0; k < 2; ++k) dst[m][k] = *(const PG8_LAS bf16x8*)(lds + PG8_SA(b, h) + aoff + m * 2048 + k * 1024); } while (0)
#define PG8_LDB(dst, b, h) do { _Pragma("unroll") for (int n = 0; n < 2; ++n) _Pragma("unroll") for (int k = 0; k < 2; ++k) dst[n][k] = *(const PG8_LAS bf16x8*)(lds + PG8_SB(b, h) + boff + n * 2048 + k * 1024); } while (0)
#define PG8_MMA(ai, bj, At, Bt) do { __builtin_amdgcn_s_setprio(1); _Pragma("unroll") for (int m = 0; m < 4; ++m) _Pragma("unroll") for (int n = 0; n < 2; ++n) _Pragma("unroll") for (int k = 0; k < 2; ++k) \
        acc[ai][bj][m][n] = __builtin_amdgcn_mfma_f32_16x16x32_bf16(Bt[n][k], At[m][k], acc[ai][bj][m][n], 0, 0, 0); __builtin_amdgcn_s_setprio(0); } while (0)
#define PG8_WAIT_V(n) asm volatile("s_waitcnt vmcnt(" #n ")" ::: "memory")
#define PG8_WAIT_L(n) asm volatile("s_waitcnt lgkmcnt(" #n ")" ::: "memory")
#define PG8_BAR __builtin_amdgcn_s_barrier()
#define PG8_SCHED __builtin_amdgcn_sched_barrier(0)
    Unit cur, nxt; int ui = 0;
    if (!S.next(0, cur)) return;
    f32x4 acc[2][2][4][2];
#pragma unroll
    for (int a = 0; a < 2; ++a)
#pragma unroll
        for (int b = 0; b < 2; ++b)
#pragma unroll
            for (int m = 0; m < 4; ++m)
#pragma unroll
                for (int n = 0; n < 2; ++n) acc[a][b][m][n] = (f32x4){0.f, 0.f, 0.f, 0.f};
    bf16x8 At[4][2], B0[2][2], B1[2][2];
    const char* cA = (const char*)g.A + (size_t)cur.pm * tstep + (size_t)cur.kc * kcb; const char* cB = (const char*)g.Bt + (size_t)cur.pn * tstep + (size_t)cur.kc * kcb;
    S.a_ready(cur);
    if constexpr (SP2) {
        PG8_STAGE(PG8_SB(0, 0), cB, voffB); PG8_STAGE(PG8_SB(0, 1), cB + hstep, voffB); PG8_STAGE(PG8_SA(0, 0), cA, voffA); PG8_STAGE(PG8_SA(0, 1), cA + hstep, voffA);
        if (wr == 1) PG8_BAR;
        PG8_WAIT_V(2); PG8_BAR;
        PG8_STAGE(PG8_SB(1, 0), cB + kstep, voffB); PG8_STAGE(PG8_SA(1, 0), cA + kstep, voffA); PG8_STAGE(PG8_SB(1, 1), cB + hstep + kstep, voffB);
        PG8_WAIT_V(6); PG8_BAR;
    } else {
        PG8_STAGE(PG8_SB(0, 0), cB, voffB); PG8_STAGE(PG8_SA(0, 0), cA, voffA); PG8_STAGE(PG8_SB(0, 1), cB + hstep, voffB); PG8_STAGE(PG8_SA(0, 1), cA + hstep, voffA);
        if (wr == 1) PG8_BAR;
        PG8_WAIT_V(4); PG8_BAR;
        PG8_STAGE(PG8_SB(1, 0), cB + kstep, voffB); PG8_STAGE(PG8_SA(1, 0), cA + kstep, voffA); PG8_STAGE(PG8_SB(1, 1), cB + hstep + kstep, voffB);
        PG8_WAIT_V(6); PG8_BAR;
    }
    for (;;) {
        const bool has_next = S.next(ui + 1, nxt);
        const char* nA = has_next ? (const char*)g.A + (size_t)nxt.pm * tstep + (size_t)nxt.kc * kcb : cA; const char* nB = has_next ? (const char*)g.Bt + (size_t)nxt.pn * tstep + (size_t)nxt.kc * kcb : cB;
        for (int t = 0; t < nt; t += 2) {
            const bool last = (t == nt - 2);
            const char* a1 = cA + (size_t)(t + 1) * kstep;
            const char* a2 = last ? nA : cA + (size_t)(t + 2) * kstep; const char* b2 = last ? nB : cB + (size_t)(t + 2) * kstep;
            const char* a3 = a2 + kstep; const char* b3 = b2 + kstep;
            if (last && has_next) S.a_ready(nxt);
            if constexpr (SP2) {
            PG8_LDB(B0, 0, 0); PG8_LDB(B1, 0, 1); PG8_SCHED; PG8_LDA(At, 0, 0); PG8_STAGE(PG8_SA(1, 1), a1 + hstep, voffA);
            PG8_WAIT_V(8); PG8_WAIT_L(0); PG8_BAR; PG8_MMA(0, 0, At, B0); PG8_MMA(0, 1, At, B1); PG8_BAR; PG8_SCHED;
            PG8_LDA(At, 0, 1); PG8_STAGE(PG8_SB(0, 0), b2, voffB); PG8_STAGE(PG8_SB(0, 1), b2 + hstep, voffB); PG8_STAGE(PG8_SA(0, 0), a2, voffA);
            PG8_WAIT_V(8); PG8_WAIT_L(0); PG8_BAR; PG8_MMA(1, 0, At, B0); PG8_MMA(1, 1, At, B1); PG8_BAR; PG8_SCHED;
            PG8_LDB(B0, 1, 0); PG8_LDB(B1, 1, 1); PG8_SCHED; PG8_LDA(At, 1, 0); PG8_STAGE(PG8_SA(0, 1), a2 + hstep, voffA);
            PG8_WAIT_V(8); PG8_WAIT_L(0); PG8_BAR; PG8_MMA(0, 0, At, B0); PG8_MMA(0, 1, At, B1); PG8_BAR; PG8_SCHED;
            PG8_LDA(At, 1, 1); PG8_STAGE(PG8_SB(1, 0), b3, voffB); PG8_STAGE(PG8_SB(1, 1), b3 + hstep, voffB); PG8_STAGE(PG8_SA(1, 0), a3, voffA);
            PG8_WAIT_V(8); PG8_WAIT_L(0); PG8_BAR; PG8_MMA(1, 0, At, B0); PG8_MMA(1, 1, At, B1); PG8_BAR; PG8_SCHED;
            } else {
            PG8_LDB(B0, 0, 0); PG8_SCHED; PG8_LDA(At, 0, 0); PG8_STAGE(PG8_SA(1, 1), a1 + hstep, voffA);
            PG8_WAIT_L(8); PG8_BAR; PG8_WAIT_L(0); PG8_MMA(0, 0, At, B0); PG8_BAR; PG8_SCHED;
            PG8_LDB(B1, 0, 1); PG8_STAGE(PG8_SB(0, 0), b2, voffB);
            PG8_BAR; PG8_WAIT_L(0); PG8_MMA(0, 1, At, B1); PG8_BAR;
            PG8_LDA(At, 0, 1); PG8_STAGE(PG8_SA(0, 0), a2, voffA);
            PG8_BAR; PG8_WAIT_L(0); PG8_MMA(1, 0, At, B0); PG8_BAR; PG8_SCHED;
            PG8_STAGE(PG8_SB(0, 1), b2 + hstep, voffB);
            PG8_WAIT_V(6); PG8_BAR; PG8_MMA(1, 1, At, B1); PG8_BAR;
            PG8_LDB(B0, 1, 0); PG8_SCHED; PG8_LDA(At, 1, 0); PG8_STAGE(PG8_SA(0, 1), a2 + hstep, voffA);
            PG8_WAIT_L(8); PG8_BAR; PG8_WAIT_L(0); PG8_MMA(0, 0, At, B0); PG8_BAR; PG8_SCHED;
            PG8_LDB(B1, 1, 1); PG8_STAGE(PG8_SB(1, 0), b3, voffB);
            PG8_BAR; PG8_WAIT_L(0); PG8_MMA(0, 1, At, B1); PG8_BAR;
            PG8_LDA(At, 1, 1); PG8_STAGE(PG8_SA(1, 0), a3, voffA);
            PG8_BAR; PG8_WAIT_L(0); PG8_MMA(1, 0, At, B0); PG8_BAR; PG8_SCHED;
            PG8_STAGE(PG8_SB(1, 1), b3 + hstep, voffB);
            PG8_WAIT_V(6); PG8_BAR; PG8_MMA(1, 1, At, B1); PG8_BAR;
            }
        }
        if constexpr (ALIGN_EPI) { if (wr == 0) PG8_BAR; }
        if constexpr (!Epi::AFTER_DRAIN) { E(acc, cur, wr, wc, fr, fq); S.done(cur); }
        if (!has_next) break;
#pragma unroll
        for (int a = 0; a < 2; ++a)
#pragma unroll
            for (int b = 0; b < 2; ++b)
#pragma unroll
                for (int m = 0; m < 4; ++m)
#pragma unroll
                    for (int n = 0; n < 2; ++n) acc[a][b][m][n] = (f32x4){0.f, 0.f, 0.f, 0.f};
        cur = nxt; cA = nA; cB = nB; ++ui;
        if constexpr (ALIGN_EPI) { if (wr == 1) PG8_BAR; }
    }
    PG8_WAIT_V(0);
    if constexpr (!ALIGN_EPI) { if (wr == 0) PG8_BAR; }
    PG8_BAR;
    if constexpr (Epi::AFTER_DRAIN) { E.fused(acc, cur, wr, wc, fr, fq, lds, wid, lane); S.done(cur); }
#undef PG8_SA
#undef PG8_SB
#undef PG8_STAGE
#undef PG8_LDA
#undef PG8_LDB
#undef PG8_MMA
#undef PG8_WAIT_V
#undef PG8_WAIT_L
#undef PG8_BAR
#undef PG8_SCHED
}
}

#define LAS __attribute__((address_space(3)))
typedef unsigned short bf16_t;
typedef short bf16x8 __attribute__((ext_vector_type(8)));
typedef short s16x4 __attribute__((ext_vector_type(4)));
typedef float f32x4 __attribute__((ext_vector_type(4)));
typedef float f32x16 __attribute__((ext_vector_type(16)));
typedef unsigned u32x4 __attribute__((ext_vector_type(4)));
typedef unsigned u32x2 __attribute__((ext_vector_type(2)));
typedef float f32x2_t __attribute__((ext_vector_type(2)));
typedef __bf16 bf16x2_t __attribute__((ext_vector_type(2)));

constexpr int T = 34816, TP = 32768, DM = 1024, NIN = 7168, FF = 4096, SEQP = 8192;
constexpr float EPS = 1e-6f;
constexpr float QSCALE = 0.125f * 1.4426950408889634f;
constexpr size_t O_Y = 0, O_KP = 35651584, O_VP = 69206016, O_CP = 102760448, O_LP = 102772736, O_KS = 102776832, O_VS = 104873984, O_CS = 106971136, O_LS = 107069440;
constexpr size_t SLOT = (size_t)T * 1024 * 2;
constexpr size_t WS_WIN = 0, WS_WBA = 14680064, WS_WBL = WS_WBA + 2097152, WS_WO = WS_WBL + 2097152, WS_WUP = WS_WO + 2097152, WS_WDN = WS_WUP + 8388608,
                 WS_WR = WS_WDN + 8388608, WS_WI = WS_WR + 131072, WS_AGG = WS_WI + 131072, WS_RSS = WS_AGG + 4194304, WS_CTL = WS_RSS + (size_t)34816 * 64, WS_CARRY = WS_CTL + 256, WS_XB = WS_CARRY + 2097152, WS_SLOT0 = 50331648;
static_assert(WS_XB + 16384 <= WS_SLOT0, "ws map");
constexpr size_t WS_END = WS_SLOT0 + 6 * SLOT;
constexpr int LDS_BYTES = 147456;
#ifndef PROBE_FLAGS
#define PROBE_FLAGS 0
#endif
#ifndef REPMASK
#define REPMASK 0
#endif
#define REPN(k) ((((REPMASK) >> (k)) & 1) ? 2 : 1)

struct Args {
    const float *x_prompt, *x_sample, *cache_k, *cache_v, *state_conv, *state_lru, *norm_mix, *norm_mlp, *norm_final, *w_in, *lambda_q, *lambda_k, *head_gain,
        *conv_w, *conv_b, *w_rgate, *b_rgate, *w_igate, *b_igate, *lru_lambda, *w_ba, *w_bl, *w_o, *w_up, *w_down;
    float* out; unsigned char* ws; int ph_lo, ph_hi, flags, pad;
};

__device__ __forceinline__ unsigned pk2(float lo, float hi) { f32x2_t v = {lo, hi}; bf16x2_t b = __builtin_convertvector(v, bf16x2_t); return __builtin_bit_cast(unsigned, b); }
__device__ __forceinline__ bf16_t f2bf(float f) { __bf16 b = (__bf16)f; return __builtin_bit_cast(unsigned short, b); }
__device__ __forceinline__ float bf2f(bf16_t u) { return __uint_as_float(((unsigned)u) << 16); }
__device__ __forceinline__ float bflo(unsigned u) { return __uint_as_float(u << 16); }
__device__ __forceinline__ float bfhi(unsigned u) { return __uint_as_float(u & 0xffff0000u); }
__device__ __forceinline__ float fsigmoid(float x) { return __builtin_amdgcn_rcpf(1.0f + __builtin_amdgcn_exp2f(-1.4426950408889634f * x)); }
__device__ __forceinline__ float gelu_tanh(float x) { const float y = 0.7978845608028654f * (x + 0.044715f * x * x * x); return x * fsigmoid(2.0f * y); }
__device__ __forceinline__ u32x4 pack8(const f32x4& a, const f32x4& b) { u32x4 w; w.x = pk2(a[0], a[1]); w.y = pk2(a[2], a[3]); w.z = pk2(b[0], b[1]); w.w = pk2(b[2], b[3]); return w; }
__device__ __forceinline__ int crow(int r, int hi) { return (r & 3) + 8 * (r >> 2) + 4 * hi; }
#define LDS_FENCE() asm volatile("s_waitcnt lgkmcnt(0)" ::: "memory")
#define MFMA32(a, b, c) __builtin_amdgcn_mfma_f32_32x32x16_bf16((a), (b), (c), 0, 0, 0)

using pg8::Unit;
#define EPI_LOOP(...) _Pragma("unroll") for (int ai = 0; ai < 2; ++ai) _Pragma("unroll") for (int m = 0; m < 4; ++m) { const int row = rbase + ai * 128 + m * 16; \
    _Pragma("unroll") for (int bj = 0; bj < 2; ++bj) { const int col = cbase + bj * 128; const f32x4 v0 = acc[ai][bj][m][0], v1 = acc[ai][bj][m][1]; __VA_ARGS__ } }

struct EpiIn {
    static constexpr bool PERM = true, AFTER_DRAIN = false;
    bf16_t *Q, *Kb, *VT, *XL, *GG, *GA, *GB; float* out;
    __device__ __forceinline__ void operator()(const f32x4 (&acc)[2][2][4][2], const Unit& u, int wr, int wc, int fr, int fq) const {
        const int sec = u.pn >> 2;
        const int cbase = (u.pn & 3) * 256 + wc * 32 + 8 * fq;
        const int rbase = u.pm * 256 + wr * 64 + fr;
        const bool prompt = u.pm < 128;
        if (sec == 0) {
            EPI_LOOP({ *(u32x4*)(Q + (size_t)row * 1024 + col) = pack8(v0 * QSCALE, v1 * QSCALE); })
        } else if (sec == 1) {
            float* ko = prompt ? out + O_KP : out + O_KS - (size_t)TP * 1024;
            EPI_LOOP({ float* o = ko + (size_t)row * 1024 + col; *(f32x4*)o = v0; *(f32x4*)(o + 4) = v1; *(u32x4*)(Kb + (size_t)row * 1024 + col) = pack8(v0, v1); })
        } else if (sec == 2) {
            float* vo = prompt ? out + O_VP : out + O_VS - (size_t)TP * 1024;
            EPI_LOOP({ float* o = vo + (size_t)row * 1024 + col; *(f32x4*)o = v0; *(f32x4*)(o + 4) = v1; *(u32x4*)(VT + (size_t)row * 1024 + col) = pack8(v0, v1); })
        } else if (sec == 3) {
            EPI_LOOP({ *(u32x4*)(XL + (size_t)row * 1024 + col) = pack8(v0, v1);
                if (prompt) { const int pos = row & (SEQP - 1); if (pos >= SEQP - 3) { float* o = out + O_CP + (size_t)((row >> 13) * 3 + pos - (SEQP - 3)) * 1024 + col; *(f32x4*)o = v0; *(f32x4*)(o + 4) = v1; } }
                else { const int rs = row - TP; const int pos = rs & 63; if (pos >= 61) { float* o = out + O_CS + (size_t)((rs >> 6) * 3 + pos - 61) * 1024 + col; *(f32x4*)o = v0; *(f32x4*)(o + 4) = v1; } } })
        } else if (sec == 4) {
            EPI_LOOP({ f32x4 a, b; _Pragma("unroll") for (int j = 0; j < 4; ++j) { a[j] = gelu_tanh(v0[j]); b[j] = gelu_tanh(v1[j]); }
                *(u32x4*)(GG + (size_t)row * 1024 + col) = pack8(a, b); })
        } else {
            bf16_t* G = (sec == 5) ? GA : GB;
            EPI_LOOP({ f32x4 a, b; _Pragma("unroll") for (int j = 0; j < 4; ++j) { a[j] = fsigmoid(v0[j]); b[j] = fsigmoid(v1[j]); }
                *(u32x4*)(G + (size_t)row * 1024 + col) = pack8(a, b); })
        }
    }
};
__device__ __forceinline__ void unpack8(const u32x4 w, f32x4& a, f32x4& b) { a[0] = bflo(w.x); a[1] = bfhi(w.x); a[2] = bflo(w.y); a[3] = bfhi(w.y); b[0] = bflo(w.z); b[1] = bfhi(w.z); b[2] = bflo(w.w); b[3] = bfhi(w.w); }
struct EpiM1 {
    static constexpr bool PERM = true, AFTER_DRAIN = false;
    const bf16_t* G; bf16_t* O;
    __device__ __forceinline__ void operator()(const f32x4 (&acc)[2][2][4][2], const Unit& u, int wr, int wc, int fr, int fq) const {
        const int cbase = u.pn * 256 + wc * 32 + 8 * fq, rbase = u.pm * 256 + wr * 64 + fr;
        EPI_LOOP({ f32x4 g0, g1; unpack8(*(const u32x4*)(G + (size_t)row * 1024 + col), g0, g1); *(u32x4*)(O + (size_t)row * 1024 + col) = pack8(g0 * v0, g1 * v1); })
    }
};
struct EpiM2 {
    static constexpr bool PERM = true, AFTER_DRAIN = false;
    const bf16_t* G; const bf16_t* Tm; bf16_t* O;
    __device__ __forceinline__ void operator()(const f32x4 (&acc)[2][2][4][2], const Unit& u, int wr, int wc, int fr, int fq) const {
        const int cbase = u.pn * 256 + wc * 32 + 8 * fq, rbase = u.pm * 256 + wr * 64 + fr;
        EPI_LOOP({ f32x4 g0, g1, t0, t1; unpack8(*(const u32x4*)(G + (size_t)row * 1024 + col), g0, g1); unpack8(*(const u32x4*)(Tm + (size_t)row * 1024 + col), t0, t1);
            *(u32x4*)(O + (size_t)row * 1024 + col) = pack8(t0 + g0 * v0, t1 + g1 * v1); })
    }
};
struct EpiO {
    static constexpr bool PERM = true, AFTER_DRAIN = false;
    const float *xp, *xs; float* H; bf16_t* HB; float* RSS;
    __device__ __forceinline__ void operator()(const f32x4 (&acc)[2][2][4][2], const Unit& u, int wr, int wc, int fr, int fq) const {
        const int cbase = u.pn * 256 + wc * 32 + 8 * fq, rbase = u.pm * 256 + wr * 64 + fr;
        const float* xb = (u.pm < 128) ? xp : xs - (size_t)TP * 1024;
#pragma unroll
        for (int ai = 0; ai < 2; ++ai)
#pragma unroll
            for (int m = 0; m < 4; ++m) { const int row = rbase + ai * 128 + m * 16; float ss = 0.f;
#pragma unroll
                for (int bj = 0; bj < 2; ++bj) { const int col = cbase + bj * 128; const float* xr = xb + (size_t)row * 1024 + col;
                    const f32x4 h0 = *(const f32x4*)xr + acc[ai][bj][m][0], h1 = *(const f32x4*)(xr + 4) + acc[ai][bj][m][1];
                    float* o = H + (size_t)row * 1024 + col; *(f32x4*)o = h0; *(f32x4*)(o + 4) = h1;
                    *(u32x4*)(HB + (size_t)row * 1024 + col) = pack8(h0, h1);
                    ss += (h0[0] * h0[0] + h0[1] * h0[1]) + (h0[2] * h0[2] + h0[3] * h0[3]) + (h1[0] * h1[0] + h1[1] * h1[1]) + (h1[2] * h1[2] + h1[3] * h1[3]); }
                ss += __shfl_xor(ss, 16); ss += __shfl_xor(ss, 32);
                if (fq == 0) RSS[(size_t)row * 16 + u.pn * 4 + wc] = ss; }
    }
};
struct EpiUp {
    static constexpr bool PERM = true, AFTER_DRAIN = false;
    const float* RSS; bf16_t* UP;
    __device__ __forceinline__ void operator()(const f32x4 (&acc)[2][2][4][2], const Unit& u, int wr, int wc, int fr, int fq) const {
        const int cbase = u.pn * 256 + wc * 32 + 8 * fq, rbase = u.pm * 256 + wr * 64 + fr;
#pragma unroll
        for (int ai = 0; ai < 2; ++ai)
#pragma unroll
            for (int m = 0; m < 4; ++m) { const int row = rbase + ai * 128 + m * 16;
                const f32x4* rp = (const f32x4*)(RSS + (size_t)row * 16); const f32x4 s = (rp[0] + rp[1]) + (rp[2] + rp[3]);
                const float rstd = __builtin_amdgcn_rsqf(((s[0] + s[1]) + (s[2] + s[3])) * (1.0f / 1024.0f) + EPS);
#pragma unroll
                for (int bj = 0; bj < 2; ++bj) { const int col = cbase + bj * 128; f32x4 a = acc[ai][bj][m][0] * rstd, b = acc[ai][bj][m][1] * rstd;
#pragma unroll
                    for (int j = 0; j < 4; ++j) { a[j] = fmaxf(a[j], 0.f); a[j] *= a[j]; b[j] = fmaxf(b[j], 0.f); b[j] *= b[j]; }
                    *(u32x4*)(UP + (size_t)row * FF + col) = pack8(a, b); } }
    }
};
struct EpiDown {
    static constexpr bool PERM = true, AFTER_DRAIN = false;
    float* H;
    __device__ __forceinline__ void operator()(const f32x4 (&acc)[2][2][4][2], const Unit& u, int wr, int wc, int fr, int fq) const {
        const int cbase = u.pn * 256 + wc * 32 + 8 * fq, rbase = u.pm * 256 + wr * 64 + fr;
        EPI_LOOP({ float* o = H + (size_t)row * 1024 + col; const f32x4 h0 = *(const f32x4*)o + v0, h1 = *(const f32x4*)(o + 4) + v1; *(f32x4*)o = h0; *(f32x4*)(o + 4) = h1; })
    }
};

struct EpiPart {
    static constexpr bool PERM = true, AFTER_DRAIN = false;
    float* PART;
    __device__ __forceinline__ void operator()(const f32x4 (&acc)[2][2][4][2], const Unit& u, int wr, int wc, int fr, int fq) const {
        const int cbase = u.pn * 256 + wc * 32 + 8 * fq, rbase = u.pm * 256 + wr * 64 + fr;
        float* pb = PART + (size_t)u.kc * 2048 * 1024;
        EPI_LOOP({ float* o = pb + (size_t)(row - TP) * 1024 + col; *(f32x4*)o = v0; *(f32x4*)(o + 4) = v1; })
    }
};
struct SplitOrder {
    int G, c;
    __device__ __forceinline__ bool next(int i, Unit& u) const { const int L = i * G + c; if (L >= 256) return false; u.pm = 128 + (L >> 5); const int r = L & 31; u.pn = r >> 3; u.kc = r & 7; return true; }
    __device__ __forceinline__ void a_ready(const Unit&) const {}
    __device__ __forceinline__ void done(const Unit&) const {}
};
__device__ __forceinline__ float wave_sum(float v) {
#pragma unroll
    for (int o = 1; o < 64; o <<= 1) v += __shfl_xor(v, o);
    return v;
}
__device__ __forceinline__ void transpose_item(const float* __restrict__ W, int K, int N, const float* __restrict__ kscale, bf16_t* WT, LAS float* scr, int item, int lane) {
    const int nblk = N / 32, kb = item / nblk, nb = item % nblk, k0 = 64 * kb, n0 = 32 * nb;
#pragma unroll 8
    for (int i = 0; i < 32; ++i) { const int kk = 2 * i + (lane >> 5); float v = W[(size_t)(k0 + kk) * N + n0 + (lane & 31)]; if (kscale) v *= kscale[k0 + kk]; scr[kk * 33 + (lane & 31)] = v; }
    LDS_FENCE();
    const int c = lane & 7;
#pragma unroll
    for (int j = 0; j < 4; ++j) { const int n = (lane >> 3) + 8 * j; const LAS float* s = scr + (8 * c) * 33 + n;
        u32x4 o; o.x = pk2(s[0 * 33], s[1 * 33]); o.y = pk2(s[2 * 33], s[3 * 33]); o.z = pk2(s[4 * 33], s[5 * 33]); o.w = pk2(s[6 * 33], s[7 * 33]);
        *(u32x4*)(WT + (size_t)(n0 + n) * K + k0 + 8 * c) = o; }
    LDS_FENCE();
}

struct LruP { const bf16_t *XL, *GG, *WRt, *WIt; bf16_t* BO; bf16_t *LA, *U; float* AGG; const float* CARRY; const float *conv_w, *conv_b, *b_r, *b_i, *lam, *state_conv, *state_lru; float* out; };
template <bool FINAL>
__device__ __forceinline__ void lru_item(const LruP& p, LAS char* scr, int tl, int n, int lane) {
    const int l31 = lane & 31, hi = lane >> 5;
    const bool samp = tl >= 512; const int bs = tl - 512, c = tl & 127, bp = tl >> 7;
    const size_t tok0 = (size_t)tl * 64;
    LAS bf16_t* sx = (LAS bf16_t*)scr;
    const unsigned lvoff = (unsigned)((4 * hi * 1024 + l31) * 2);
    {
        const int ch = n * 64 + lane;
        const float w0 = p.conv_w[ch], w1 = p.conv_w[1024 + ch], w2 = p.conv_w[2048 + ch], w3 = p.conv_w[3072 + ch], cb = p.conv_b[ch];
        float x0, x1, x2;
        if (samp) { x0 = p.state_conv[(size_t)(bs * 3 + 0) * 1024 + ch]; x1 = p.state_conv[(size_t)(bs * 3 + 1) * 1024 + ch]; x2 = p.state_conv[(size_t)(bs * 3 + 2) * 1024 + ch]; }
        else if (c == 0) { x0 = 0.f; x1 = 0.f; x2 = 0.f; }
        else { x0 = bf2f(p.XL[(tok0 - 3) * 1024 + ch]); x1 = bf2f(p.XL[(tok0 - 2) * 1024 + ch]); x2 = bf2f(p.XL[(tok0 - 1) * 1024 + ch]); }
        LAS char* raw = scr + 9216;
        { const char* gx = (const char*)(p.XL + tok0 * 1024 + n * 64); const unsigned go = (unsigned)((lane >> 3) * 2048 + (lane & 7) * 16);
          u32x4 v[8];
#pragma unroll
          for (int i = 0; i < 8; ++i) v[i] = *(const u32x4*)(gx + (size_t)i * 8 * 2048 + go);
#pragma unroll
          for (int i = 0; i < 8; ++i) *(LAS u32x4*)(raw + ((lane >> 3) + 8 * i) * 128 + (lane & 7) * 16) = v[i]; }
        LDS_FENCE();
#pragma unroll 16
        for (int t = 0; t < 64; ++t) { const float x3 = bf2f(*(const LAS bf16_t*)(raw + t * 128 + lane * 2)); const float xc = cb + w0 * x0 + w1 * x1 + w2 * x2 + w3 * x3; sx[t * 72 + lane] = f2bf(xc); x0 = x1; x1 = x2; x2 = x3; }
    }
    LDS_FENCE();
    for (int nt = 0; nt < 2; ++nt) {
        const int chd = n * 64 + 32 * nt + l31;
        f32x16 R[2], I[2];
#pragma unroll
        for (int r = 0; r < 16; ++r) { R[0][r] = 0.f; R[1][r] = 0.f; I[0][r] = 0.f; I[1][r] = 0.f; }
#pragma unroll
        for (int kk = 0; kk < 4; ++kk) {
            const bf16x8 br = *(const bf16x8*)(p.WRt + (size_t)chd * 64 + 16 * kk + 8 * hi);
            const bf16x8 bi = *(const bf16x8*)(p.WIt + (size_t)chd * 64 + 16 * kk + 8 * hi);
#pragma unroll
            for (int mt = 0; mt < 2; ++mt) { const bf16x8 a = *(const LAS bf16x8*)(scr + (32 * mt + l31) * 144 + (16 * kk + 8 * hi) * 2); R[mt] = MFMA32(a, br, R[mt]); I[mt] = MFMA32(a, bi, I[mt]); }
        }
        const float brv = p.b_r[chd], biv = p.b_i[chd];
        const float sp8 = -8.0f * log1pf(__expf(-p.lam[chd]));
#pragma unroll
        for (int mt = 0; mt < 2; ++mt)
#pragma unroll
            for (int r = 0; r < 16; ++r) { const int t = 32 * mt + crow(r, hi); const float xcv = bf2f(sx[t * 72 + 32 * nt + l31]);
                const float rg = fsigmoid(R[mt][r] + brv), ig = fsigmoid(I[mt][r] + biv);
                const bf16_t lab = f2bf(rg * sp8); const float la = bf2f(lab), av = __builtin_amdgcn_exp2f(la * 1.4426950408889634f), x2 = 2.0f * la;
                const float ser = -x2 * (1.0f + x2 * (0.5f + x2 * (0.16666667f + x2 * (0.041666668f + x2 * 0.008333334f))));
                const float om = (x2 > -0.25f) ? ser : (1.0f - av * av);
                const bf16_t ub16 = f2bf(__builtin_amdgcn_sqrtf(om) * ig * xcv);
                R[mt][r] = av; I[mt][r] = bf2f(ub16);
                if (!FINAL) { const size_t ub = ((tok0 + 32 * mt + (r & 3) + 8 * (r >> 2)) * 1024 + n * 64 + 32 * nt) * 2;
                    *(bf16_t*)((char*)p.LA + ub + lvoff) = lab; *(bf16_t*)((char*)p.U + ub + lvoff) = ub16; } }
        float oA[8], oH[8], pA[8], pH[8];
#pragma unroll
        for (int gi = 0; gi < 8; ++gi) { float A = 1.f, H = 0.f;
#pragma unroll
            for (int j = 0; j < 4; ++j) { const float a = R[gi >> 2][(gi & 3) * 4 + j]; H = a * H + I[gi >> 2][(gi & 3) * 4 + j]; A *= a; }
            oA[gi] = A; oH[gi] = H; pA[gi] = __shfl_xor(A, 32); pH[gi] = __shfl_xor(H, 32); }
        float h = 0.f;
        if (FINAL) {
            if (samp) h = p.state_lru[(size_t)bs * 1024 + chd];
            else h = p.CARRY[(size_t)tl * 1024 + chd];
        }
        float cin[8], Atot = 1.f;
#pragma unroll
        for (int k = 0; k < 8; ++k) { const float Alo = hi ? pA[k] : oA[k], Hlo = hi ? pH[k] : oH[k], Ahi = hi ? oA[k] : pA[k], Hhi = hi ? oH[k] : pH[k];
            const float hm = Alo * h + Hlo; cin[k] = hi ? hm : h; h = Ahi * hm + Hhi; Atot *= Alo * Ahi; }
        if (!FINAL) { if (hi == 0 && !samp) { p.AGG[(size_t)tl * 2048 + chd] = Atot; p.AGG[(size_t)tl * 2048 + 1024 + chd] = h; } }
        else {
#pragma unroll
            for (int gi = 0; gi < 8; ++gi) { float hh = cin[gi];
#pragma unroll
                for (int j = 0; j < 4; ++j) { const int r = (gi & 3) * 4 + j, mt = gi >> 2; hh = R[mt][r] * hh + I[mt][r]; const size_t ub = ((tok0 + 32 * mt + (r & 3) + 8 * (r >> 2)) * 1024 + n * 64 + 32 * nt) * 2;
                    *(bf16_t*)((char*)p.BO + ub + lvoff) = f2bf(hh * bf2f(*(const bf16_t*)((const char*)p.GG + ub + lvoff))); } }
            if (hi == 0) { if (samp) p.out[O_LS + (size_t)bs * 1024 + chd] = h; else if (c == 127) p.out[O_LP + (size_t)bp * 1024 + chd] = h; }
        }
    }
    LDS_FENCE();
}

__device__ __forceinline__ void lru_final_light(const LruP& p, int tl, int n, int lane) {
    const bool samp = tl >= 512; const int bs = tl - 512, c = tl & 127, bp = tl >> 7; const size_t tok0 = (size_t)tl * 64;
    const int ch = n * 64 + lane; const unsigned l2 = (unsigned)lane * 2u;
    float h = samp ? p.state_lru[(size_t)bs * 1024 + ch] : p.CARRY[(size_t)tl * 1024 + ch];
#pragma unroll 16
    for (int t = 0; t < 64; ++t) { const size_t ub = ((tok0 + t) * 1024 + n * 64) * 2;
        const float la = bf2f(*(const bf16_t*)((const char*)p.LA + ub + l2)), u = bf2f(*(const bf16_t*)((const char*)p.U + ub + l2)), gg = bf2f(*(const bf16_t*)((const char*)p.GG + ub + l2));
        h = __builtin_amdgcn_exp2f(la * 1.4426950408889634f) * h + u;
        *(bf16_t*)((char*)p.BO + ub + l2) = f2bf(h * gg); }
    if (samp) p.out[O_LS + (size_t)bs * 1024 + ch] = h; else if (c == 127) p.out[O_LP + (size_t)bp * 1024 + ch] = h;
}
constexpr int AT_KB = 16384, AT_BUF = 32768, AT_EXCH = 2 * AT_BUF, AT_WSF = AT_EXCH + 65536;
static_assert(AT_WSF + 2048 <= LDS_BYTES, "attention LDS map");
typedef short v4i16_t __attribute__((ext_vector_type(4)));
struct AttP { const bf16_t *Q, *Kb, *VT; bf16_t* AO; const float *cache_k, *cache_v, *head_gain; int flags; };
template <bool SAMPLE>
__device__ __forceinline__ void attn_unit(const AttP& p, LAS char* lds, int b, int h, int qb, float lam) {
    const int tid = threadIdx.x, lane = tid & 63, l31 = lane & 31, hi = lane >> 5;
    const int w = __builtin_amdgcn_readfirstlane(tid >> 6), c = w >> 2, wq = w & 3;
    const size_t tok0 = SAMPLE ? (size_t)(TP + b * 64) : (size_t)b * SEQP;
    const int q0 = SAMPLE ? 0 : qb * 128;
    const int NT = SAMPLE ? 17 : 2 * qb + 2;
    const bool active = SAMPLE ? (wq < 2) : true;
    const int myNT = SAMPLE ? 17 : (wq < 2 ? NT - 1 : NT);
    LAS float* wsf = (LAS float*)(lds + AT_WSF) + w * 64;
    const int kfo = l31 * 256, kfx = (c * 8 + hi) ^ (l31 & 15);
    const int vq = (lane & 15) >> 2, vfo = (4 * hi + vq) * 256 + ((lane >> 4) & 1) * 32 + (lane & 3) * 8;
    const unsigned aovoff = (unsigned)((4 * hi * 1024 + l31) * 2);
    bf16x8 qf[4];
    { const bf16_t* qp = p.Q + (tok0 + q0 + (active ? wq : 0) * 32 + l31) * 1024 + h * 128 + c * 64 + hi * 8;
#pragma unroll
      for (int d0 = 0; d0 < 4; ++d0) qf[d0] = *(const bf16x8*)(qp + d0 * 16); }
    f32x16 O[4];
#pragma unroll
    for (int dt = 0; dt < 4; ++dt)
#pragma unroll
        for (int r = 0; r < 16; ++r) O[dt][r] = 0.f;
    float mrun = 0.f, lrun = 0.f;
    u32x4 st[4];
    if (!SAMPLE) { st[0] = st[1] = st[2] = st[3] = (u32x4){0u, 0u, 0u, 0u}; }
    const unsigned coff_l = (unsigned)(((tid >> 5) * 1024 + (tid & 31) * 4) * 4);
    unsigned ksrc[2], vsrc[2];
#pragma unroll
    for (int i = 0; i < 2; ++i) { const int row = 4 * (w * 2 + i) + (lane >> 4), chp = lane & 15;
        ksrc[i] = (unsigned)((row * 1024 + (chp ^ (row & 15)) * 8) * 2); vsrc[i] = (unsigned)((row * 1024 + (chp ^ ((row & 3) << 2)) * 8) * 2); }
#define DMA_K(trow_, buf_) do { const char* gk_ = (const char*)(p.Kb + (size_t)(trow_) * 1024 + h * 128); _Pragma("unroll") for (int i = 0; i < 2; ++i) \
            __builtin_amdgcn_global_load_lds((const unsigned*)(gk_ + ksrc[i]), (LAS unsigned*)(lds + (buf_) * AT_BUF + (w * 2 + i) * 1024), 16, 0, 0); } while (0)
#define DMA_V(trow_, buf_) do { const char* gv_ = (const char*)(p.VT + (size_t)(trow_) * 1024 + h * 128); _Pragma("unroll") for (int i = 0; i < 2; ++i) \
            __builtin_amdgcn_global_load_lds((const unsigned*)(gv_ + vsrc[i]), (LAS unsigned*)(lds + (buf_) * AT_BUF + AT_KB + (w * 2 + i) * 1024), 16, 0, 0); } while (0)
#define LOAD_F32(src_, t_) do { _Pragma("unroll") for (int i = 0; i < 4; ++i) { \
            st[i] = *(const u32x4*)((const char*)((src_) + (((size_t)b * 1024 + (t_) * 64 + 16 * i) * 8 + h) * 128) + coff_l); } } while (0)
#define STORE_F32(buf_, boff_, isv_) do { LAS char* kb_ = lds + (buf_) * AT_BUF + (boff_); _Pragma("unroll") for (int i = 0; i < 4; ++i) { const int id = tid + 512 * i; const int row = id >> 5, c4 = id & 31; \
            u32x2 kk; kk.x = pk2(__uint_as_float(st[i][0]), __uint_as_float(st[i][1])); kk.y = pk2(__uint_as_float(st[i][2]), __uint_as_float(st[i][3])); \
            const int sw_ = (isv_) ? ((row & 3) << 2) : (row & 15); \
            *(LAS u32x2*)(kb_ + row * 256 + (((c4 >> 1) ^ sw_) << 4) + (c4 & 1) * 8) = kk; } } while (0)
    if (SAMPLE) { LOAD_F32(p.cache_k, 0); STORE_F32(0, 0, 0); } else { DMA_K(tok0, 0); }
    __syncthreads();
    mrun = 0.f;
    bf16x8 pa0, pa1, pa2, pa3;
    pa0 = pa1 = pa2 = pa3 = (bf16x8){0, 0, 0, 0, 0, 0, 0, 0};
#define VLOAD(dst_, s_) do { _Pragma("unroll") for (int dt = 0; dt < 4; ++dt) { LAS char* vp = vb + vfo + ((dt ^ vq) << 6) + (16 * (s_)) * 256; \
                    const v4i16_t lo_ = __builtin_amdgcn_ds_read_tr16_b64_v4i16((LAS v4i16_t*)vp), hh_ = __builtin_amdgcn_ds_read_tr16_b64_v4i16((LAS v4i16_t*)(vp + 8 * 256)); \
                    dst_[dt] = __builtin_shufflevector(lo_, hh_, 0, 1, 2, 3, 4, 5, 6, 7); } } while (0)
#define PKP(P_, q_) __builtin_bit_cast(bf16x8, (u32x4){pk2(P_[8 * q_ + 0], P_[8 * q_ + 1]), pk2(P_[8 * q_ + 2], P_[8 * q_ + 3]), pk2(P_[8 * q_ + 4], P_[8 * q_ + 5]), pk2(P_[8 * q_ + 6], P_[8 * q_ + 7])})
#define PVMM(pa_, vf_) do { _Pragma("unroll") for (int dt = 0; dt < 4; ++dt) O[dt] = MFMA32(pa_, vf_[dt], O[dt]); } while (0)
#define PV_ALL() do { bf16x8 va[4]; VLOAD(va, 0); PVMM(pa0, va); VLOAD(va, 1); PVMM(pa1, va); VLOAD(va, 2); PVMM(pa2, va); VLOAD(va, 3); PVMM(pa3, va); } while (0)
#define QK_MAX(t_, kb_) \
            const bool maskt = !SAMPLE && ((t_) >= myNT);        \
            f32x16 p0, p1; \
            _Pragma("unroll") for (int r = 0; r < 16; ++r) { p0[r] = 0.f; p1[r] = 0.f; } \
            _Pragma("unroll") for (int d0 = 0; d0 < 4; ++d0) { \
                const bf16x8 k0 = *(const LAS bf16x8*)((kb_) + kfo + ((kfx ^ (d0 << 1)) << 4)); \
                const bf16x8 k1 = *(const LAS bf16x8*)((kb_) + kfo + 8192 + ((kfx ^ (d0 << 1)) << 4)); \
                p0 = MFMA32(k0, qf[d0], p0); p1 = MFMA32(k1, qf[d0], p1); } \
            __builtin_amdgcn_sched_group_barrier(0x100, 4, 0); \
            _Pragma("unroll") for (int i_ = 0; i_ < 2; ++i_) { __builtin_amdgcn_sched_group_barrier(0x008, 1, 0); __builtin_amdgcn_sched_group_barrier(0x100, 2, 0); } \
            __builtin_amdgcn_sched_group_barrier(0x008, 6, 0); \
            float rm = fmaxf(fmaxf(p0[0], p1[0]), p0[1]); \
            _Pragma("unroll") for (int r = 2; r < 16; r += 2) rm = fmaxf(fmaxf(rm, p0[r]), p0[r + 1]); \
            _Pragma("unroll") for (int r = 1; r < 16; r += 2) rm = fmaxf(fmaxf(rm, p1[r]), p1[(r + 1) & 15]); \
            rm = fmaxf(rm, __shfl_xor(rm, 32)) - mrun; \
            if (maskt) rm = 0.f; \
            const bool resc = __any(rm > 8.0f) || (t_) == 0;     \
            float alpha = 1.0f; \
            if (resc) { const float dl = (rm > 8.0f || (t_) == 0) ? rm : 0.f; alpha = __builtin_amdgcn_exp2f(-dl); mrun += dl; lrun *= alpha; } \
            const float sh = maskt ? 1e30f : mrun; \
            _Pragma("unroll") for (int r = 0; r < 16; ++r) { p0[r] -= sh; p1[r] -= sh; } \
            __builtin_amdgcn_sched_barrier(0);
#define O_RESCALE() do { if (resc) { if (hi == 0) wsf[l31] = alpha; LDS_FENCE(); \
                _Pragma("unroll") for (int r = 0; r < 16; ++r) { const float a_ = wsf[crow(r, hi)]; _Pragma("unroll") for (int dt = 0; dt < 4; ++dt) O[dt][r] *= a_; } LDS_FENCE(); } } while (0)
    if (!SAMPLE) { DMA_K(tok0 + 64, 1); DMA_V(tok0, 0); }
    if (active) {
        QK_MAX(0, lds)
        float ls = 0.f;
#pragma unroll
        for (int r = 0; r < 16; ++r) { p0[r] = __builtin_amdgcn_exp2f(p0[r]); p1[r] = __builtin_amdgcn_exp2f(p1[r]); ls += p0[r] + p1[r]; }
        lrun += ls;
        pa0 = PKP(p0, 0); pa1 = PKP(p0, 1); pa2 = PKP(p1, 0); pa3 = PKP(p1, 1);
    }
    if (SAMPLE) { LOAD_F32(p.cache_k, 1); STORE_F32(1, 0, 0); LOAD_F32(p.cache_v, 0); STORE_F32(0, AT_KB, 1); }
    __syncthreads();
    for (int t = 1; t < NT; ++t) {
        const int buf = t & 1;
        if (!SAMPLE) { if (t + 1 < NT) DMA_K(tok0 + (size_t)(t + 1) * 64, buf ^ 1); DMA_V(tok0 + (size_t)t * 64, buf); }
        else { if (t + 1 == 16) DMA_K(tok0, buf ^ 1); if (t == 16) DMA_V(tok0, buf); }
        LAS char* vb = lds + (buf ^ 1) * AT_BUF + AT_KB;
        if (active) {
            QK_MAX(t, lds + buf * AT_BUF)
            float ls = 0.f;
            bf16x8 va[4];
#define EXP8(P_, q_) do { _Pragma("unroll") for (int r = 8 * (q_); r < 8 * (q_) + 8; ++r) { P_[r] = __builtin_amdgcn_exp2f(P_[r]); ls += P_[r]; } } while (0)
            VLOAD(va, 0); EXP8(p0, 0); PVMM(pa0, va); pa0 = PKP(p0, 0);
            VLOAD(va, 1); EXP8(p0, 1); PVMM(pa1, va); pa1 = PKP(p0, 1);
            VLOAD(va, 2); EXP8(p1, 0); PVMM(pa2, va); pa2 = PKP(p1, 0);
            VLOAD(va, 3); EXP8(p1, 1); PVMM(pa3, va); pa3 = PKP(p1, 1);
#undef EXP8
            __builtin_amdgcn_sched_group_barrier(0x100, 8, 0); __builtin_amdgcn_sched_group_barrier(0x002, 8, 0);
#pragma unroll
            for (int i_ = 0; i_ < 8; ++i_) { __builtin_amdgcn_sched_group_barrier(0x008, 1, 0); __builtin_amdgcn_sched_group_barrier(0x100, 2, 0); __builtin_amdgcn_sched_group_barrier(0x002, 5, 0); }
#pragma unroll
            for (int i_ = 0; i_ < 4; ++i_) { __builtin_amdgcn_sched_group_barrier(0x008, 1, 0); __builtin_amdgcn_sched_group_barrier(0x100, 2, 0); __builtin_amdgcn_sched_group_barrier(0x002, 4, 0); }
#pragma unroll
            for (int i_ = 0; i_ < 4; ++i_) { __builtin_amdgcn_sched_group_barrier(0x008, 1, 0); __builtin_amdgcn_sched_group_barrier(0x002, 4, 0); }
            lrun += ls;
            O_RESCALE();
        }
        if (SAMPLE) { if (t + 1 < 16) { LOAD_F32(p.cache_k, t + 1); STORE_F32(buf ^ 1, 0, 0); } if (t < 16) { LOAD_F32(p.cache_v, t); STORE_F32(buf, AT_KB, 1); } }
        __syncthreads();
    }
    if (active) { LAS char* vb = lds + ((NT - 1) & 1) * AT_BUF + AT_KB; PV_ALL(); }
    __syncthreads();
#undef QK_MAX
#undef O_RESCALE
#undef VLOAD
#undef PKP
#undef PVMM
#undef PV_ALL
    if (active) {
        const float lt = lrun + __shfl_xor(lrun, 32);
        const float sc = (c == 0 ? 1.0f : lam) * __builtin_amdgcn_rcpf(lt);
        if (hi == 0) wsf[l31] = sc;
        LDS_FENCE();
#pragma unroll
        for (int r = 0; r < 16; ++r) { const float a = wsf[crow(r, hi)];
#pragma unroll
            for (int dt = 0; dt < 4; ++dt) O[dt][r] *= a; }
        LDS_FENCE();
    }
    LAS float* ex = (LAS float*)(lds + AT_EXCH) + wq * 4096;
    if (active && c == 1) {
#pragma unroll
        for (int dt = 0; dt < 4; ++dt)
#pragma unroll
            for (int r = 0; r < 16; ++r) ex[(dt * 16 + r) * 64 + lane] = O[dt][r];
    }
    __syncthreads();
    if (active && c == 0) {
        float hg[4];
#pragma unroll
        for (int dt = 0; dt < 4; ++dt) hg[dt] = p.head_gain[32 * dt + l31] * 0.8f;
#pragma unroll
        for (int r = 0; r < 16; ++r) {
            float o[4], ss = 0.f;
#pragma unroll
            for (int dt = 0; dt < 4; ++dt) { o[dt] = O[dt][r] - ex[(dt * 16 + r) * 64 + lane]; ss += o[dt] * o[dt]; }
            ss += __shfl_xor(ss, 1); ss += __shfl_xor(ss, 2); ss += __shfl_xor(ss, 4); ss += __shfl_xor(ss, 8); ss += __shfl_xor(ss, 16);
            const float rs = __builtin_amdgcn_rsqf(ss * (1.0f / 128.0f) + EPS);
            char* op = (char*)(p.AO + (tok0 + q0 + wq * 32 + (r & 3) + 8 * (r >> 2)) * 1024 + h * 128);
#pragma unroll
            for (int dt = 0; dt < 4; ++dt) *(bf16_t*)(op + 64 * dt + aovoff) = f2bf(o[dt] * rs * hg[dt]);
        }
    }
    __syncthreads();
}

#define XB_TMO      128
#define XB_XCNT(j)  (256  + 64 * (j))
#define XB_XSUB(j)  (1280 + 64 * (j))
#define XB_XGEN(j)  (2304 + 64 * (j))
#define XB_TOP      3328
#define XB_TOPGEN   3392
#define XCD_BAR_WORDS 3456
#define XB_SPIN_CAP (1u << 18)

__device__ __forceinline__ unsigned xb_ld(unsigned* p)              { return __hip_atomic_load(p, __ATOMIC_RELAXED, __HIP_MEMORY_SCOPE_AGENT); }
__device__ __forceinline__ unsigned xb_add(unsigned* p, unsigned v) { return __hip_atomic_fetch_add(p, v, __ATOMIC_RELAXED, __HIP_MEMORY_SCOPE_AGENT); }
__device__ __forceinline__ unsigned xb_xcc_id() { return (unsigned)__builtin_amdgcn_s_getreg((3 << 11) | 20) & 0xFu; }
#define XB_SPIN(cond, bar) do { unsigned _sp = 0; while (cond) { __builtin_amdgcn_s_sleep(1); \
    if ((++_sp & 255u) == 0u) { if (xb_ld(&(bar)[XB_TMO])) break; if (_sp > XB_SPIN_CAP) { atomicAdd(&(bar)[XB_TMO], 1u); break; } } } } while (0)

struct XcdBarrier {
    unsigned* bar; unsigned x;
    volatile LAS unsigned* st;
};

__device__ __forceinline__ XcdBarrier xcd_barrier_post(unsigned* bar, volatile LAS unsigned* st) {
    XcdBarrier b; b.bar = bar; b.x = xb_xcc_id(); b.st = st;
    if (threadIdx.x == 0) (void)xb_add(&bar[XB_XCNT(b.x)], 1u);
    return b;
}
__device__ __forceinline__ void xcd_barrier_complete(unsigned* bar, unsigned x, unsigned& nloc, unsigned& nx) {
    const unsigned G = gridDim.x * gridDim.y * gridDim.z;
    unsigned sum, cnt, mine, sp = 0u;
    for (;;) {
        sum = 0u; cnt = 0u; mine = 0u;
#pragma unroll
        for (unsigned j = 0; j < 16; ++j) { const unsigned c = xb_ld(&bar[XB_XCNT(j)]); sum += c; cnt += (c > 0u) ? 1u : 0u; mine = (j == x) ? c : mine; }
        if (sum == G) break;
        __builtin_amdgcn_s_sleep(1);
        if ((++sp & 255u) == 0u) { if (xb_ld(&bar[XB_TMO])) break; if (sp > XB_SPIN_CAP) { atomicAdd(&bar[XB_TMO], 1u); break; } }
    }
    nloc = mine > 0u ? mine : 1u; nx = cnt > 0u ? cnt : 1u;
}

__device__ __forceinline__ void xcd_barrier(const XcdBarrier& b) {
    asm volatile("s_waitcnt vmcnt(0)" ::: "memory");
    __syncthreads();
    if (threadIdx.x == 0) {
        unsigned* bar = b.bar;
        __builtin_amdgcn_s_waitcnt(0);
        unsigned nloc = b.st[0], nx = b.st[1];
        if (nloc == 0u) { xcd_barrier_complete(bar, b.x, nloc, nx); b.st[0] = nloc; b.st[1] = nx; }
        const unsigned old = xb_add(&bar[XB_XSUB(b.x)], 1u);
        const unsigned gen = old / nloc;
        if (old + 1u == (gen + 1u) * nloc) {
            __builtin_amdgcn_fence(__ATOMIC_RELEASE, "agent");
            asm volatile("s_waitcnt vmcnt(0)" ::: "memory");
            const unsigned og = xb_add(&bar[XB_TOP], 1u);
            const unsigned tg = og / nx;
            if (og + 1u == (tg + 1u) * nx) xb_add(&bar[XB_TOPGEN], 1u);
            else XB_SPIN(xb_ld(&bar[XB_TOPGEN]) == tg, bar);
            __builtin_amdgcn_fence(__ATOMIC_ACQUIRE, "agent");
            xb_add(&bar[XB_XGEN(b.x)], 1u);
            asm volatile("s_waitcnt vmcnt(0)" ::: "memory");
        } else {
            XB_SPIN(xb_ld(&bar[XB_XGEN(b.x)]) == gen, bar);
            __builtin_amdgcn_fence(__ATOMIC_ACQUIRE, "agent");
            asm volatile("s_waitcnt vmcnt(0)" ::: "memory");
        }
    }
    __syncthreads();
}


__device__ __forceinline__ void grid_bar(unsigned* cnt, unsigned target) {
    asm volatile("s_waitcnt vmcnt(0)" ::: "memory");
    __syncthreads();
    if (threadIdx.x == 0) {
        __builtin_amdgcn_fence(__ATOMIC_RELEASE, "agent");
        asm volatile("s_waitcnt vmcnt(0)" ::: "memory");
        __hip_atomic_fetch_add(cnt, 1u, __ATOMIC_RELAXED, __HIP_MEMORY_SCOPE_AGENT);
        while (__hip_atomic_load(cnt, __ATOMIC_RELAXED, __HIP_MEMORY_SCOPE_AGENT) < target) __builtin_amdgcn_s_sleep(2);
        __builtin_amdgcn_fence(__ATOMIC_ACQUIRE, "agent");
        asm volatile("s_waitcnt vmcnt(0)" ::: "memory");
    }
    __syncthreads();
}
__global__ void __launch_bounds__(512, 2) mega(Args a) {
    extern __shared__ __attribute__((aligned(16))) unsigned char lds_raw[];
    LAS unsigned char* lds = (LAS unsigned char*)lds_raw;
    const int tid = threadIdx.x, lane = tid & 63, wave = __builtin_amdgcn_readfirstlane(tid >> 6);
    const int G = gridDim.x, bx = blockIdx.x;
    const int vcu = (G % 8 == 0) ? (bx % 8) * (G / 8) + bx / 8 : bx;
    const int gw = vcu * 8 + wave, NGW = G * 8;
    unsigned char* ws = a.ws;
    bf16_t* WinT = (bf16_t*)(ws + WS_WIN); bf16_t* WbaT = (bf16_t*)(ws + WS_WBA); bf16_t* WblT = (bf16_t*)(ws + WS_WBL); bf16_t* WoT = (bf16_t*)(ws + WS_WO);
    bf16_t* WupT = (bf16_t*)(ws + WS_WUP); bf16_t* WdnT = (bf16_t*)(ws + WS_WDN); bf16_t* WRt = (bf16_t*)(ws + WS_WR); bf16_t* WIt = (bf16_t*)(ws + WS_WI);
    float* AGG = (float*)(ws + WS_AGG); float* RSS = (float*)(ws + WS_RSS);
    bf16_t* S0 = (bf16_t*)(ws + WS_SLOT0); bf16_t* S1 = (bf16_t*)(ws + WS_SLOT0 + SLOT); bf16_t* S2 = (bf16_t*)(ws + WS_SLOT0 + 2 * SLOT); bf16_t* S3 = (bf16_t*)(ws + WS_SLOT0 + 3 * SLOT);
    bf16_t* S4 = (bf16_t*)(ws + WS_SLOT0 + 4 * SLOT); bf16_t* S5 = (bf16_t*)(ws + WS_SLOT0 + 5 * SLOT);
    bf16_t *XN = S0, *BO = S0, *Qb = S1, *AO = S1, *Kb = S2, *MG = S2, *VT = S3, *TMP = S4, *XL = S4, *GG = S5, *HB = S5, *UP = S0;
    bf16_t* GA = (bf16_t*)(a.out + O_Y); bf16_t* GB = GA + (size_t)T * 1024;
    float* H = a.out + O_Y;
    const int lo = a.ph_lo, hi_ph = a.ph_hi;
#ifdef ONLYPH
#define IN(k) ((k) == ONLYPH && lo <= (k) && (k) < hi_ph)
#else
#define IN(k) (lo <= (k) && (k) < hi_ph)
#endif
    unsigned* barcnt = (unsigned*)(ws + WS_CTL);
    volatile LAS unsigned* xst = (volatile LAS unsigned*)(lds + LDS_BYTES - 16);
    if (tid < 2) xst[tid] = 0u;
    __syncthreads();
    const XcdBarrier xbar = xcd_barrier_post((unsigned*)(ws + WS_XB), xst);
    if (a.ph_lo < 0) cg::this_grid().sync();
#define SYNC(k) do { if (IN(k) && IN((k) + 1)) xcd_barrier(xbar); } while (0)

    if (IN(0)) for (int rep = 0; rep < REPN(0); ++rep) {
        LAS float* scr = (LAS float*)(lds + wave * 16384);
        constexpr int I_IN = 16 * 224, I_SQ = 16 * 32, I_UP = 16 * 128, I_DN = 64 * 32, I_G = 32;
        constexpr int NIT = I_IN + 3 * I_SQ + 2 * I_G;
        for (int it = gw; it < NIT; it += NGW) {
            int r = it;
            if (r < I_IN) { transpose_item(a.w_in, 1024, NIN, nullptr, WinT, scr, r, lane); continue; } r -= I_IN;
            if (r < I_SQ) { transpose_item(a.w_ba, 1024, 1024, nullptr, WbaT, scr, r, lane); continue; } r -= I_SQ;
            if (r < I_SQ) { transpose_item(a.w_bl, 1024, 1024, nullptr, WblT, scr, r, lane); continue; } r -= I_SQ;
            if (r < I_SQ) { transpose_item(a.w_o, 1024, 1024, nullptr, WoT, scr, r, lane); continue; } r -= I_SQ;
            if (r < I_G) { transpose_item(a.w_rgate + (size_t)(r >> 1) * 4096, 64, 64, nullptr, WRt + (size_t)(r >> 1) * 4096, scr, r & 1, lane); continue; } r -= I_G;
            transpose_item(a.w_igate + (size_t)(r >> 1) * 4096, 64, 64, nullptr, WIt + (size_t)(r >> 1) * 4096, scr, r & 1, lane);
        }
        f32x4 g[4];
#pragma unroll
        for (int j = 0; j < 4; ++j) g[j] = ((const f32x4*)a.norm_mix)[lane + 64 * j];
        for (int m = gw; m < T; m += NGW) {
            const float* xr = (m < TP) ? a.x_prompt + (size_t)m * 1024 : a.x_sample + (size_t)(m - TP) * 1024;
            f32x4 v[4]; float s = 0.f;
#pragma unroll
            for (int j = 0; j < 4; ++j) { v[j] = ((const f32x4*)xr)[lane + 64 * j]; s += (v[j][0] * v[j][0] + v[j][1] * v[j][1]) + (v[j][2] * v[j][2] + v[j][3] * v[j][3]); }
            const float rstd = 1.0f / sqrtf(wave_sum(s) * (1.0f / 1024.0f) + EPS);
            u32x2* o = (u32x2*)(XN + (size_t)m * 1024);
#pragma unroll
            for (int j = 0; j < 4; ++j) { u32x2 w2; w2.x = pk2(v[j][0] * rstd * g[j][0], v[j][1] * rstd * g[j][1]); w2.y = pk2(v[j][2] * rstd * g[j][2], v[j][3] * rstd * g[j][3]); o[lane + 64 * j] = w2; }
        }
    }
    SYNC(0);
    if (IN(1)) for (int rep = 0; rep < REPN(1); ++rep) {
        pg8::Gemm g{XN, WinT, T, NIN, 1024, 1024}; pg8::StaticOrder S; S.init(T, NIN, G, bx);
        EpiIn E{Qb, Kb, VT, XL, GG, GA, GB, a.out};
        pg8::gemm_phase<EpiIn, pg8::StaticOrder, true, true>(lds, g, S, E);
    }
    SYNC(1);
    float* CARRY = (float*)(ws + WS_CARRY);
    LruP lp{XL, GG, WRt, WIt, BO, S2, S3, AGG, CARRY, a.conv_w, a.conv_b, a.b_rgate, a.b_igate, a.lru_lambda, a.state_conv, a.state_lru, a.out};
    if (IN(2)) {
        float lam;
        { const float q0 = a.lambda_q[lane], k0 = a.lambda_k[lane], q1 = a.lambda_q[64 + lane], k1 = a.lambda_k[64 + lane];
          lam = __expf(wave_sum(q0 * k0)) - __expf(wave_sum(q1 * k1)) + 0.2f; }
        AttP ap{Qb, Kb, VT, AO, a.cache_k, a.cache_v, a.head_gain, a.flags};
        { const int nsamp = (vcu < 256) ? (255 - vcu) / G + 1 : 0, npr = (vcu < 1024) ? 2 * ((1023 - vcu) / G + 1) : 0;
          const int ss = nsamp ? (vcu % (npr + 1)) : -1;
          int si = 0, pi = 0;
          for (int k = 0; k < npr + nsamp; ++k) {
              const bool is_s = (si < nsamp) && (k == ss || pi >= npr);
              if (is_s) { const int u = vcu + si * G; attn_unit<true>(ap, (LAS char*)lds, u >> 3, u & 7, 0, lam); ++si; }
              else { const int pr = vcu + (pi >> 1) * G, bh = pr >> 5, s = pr & 31; attn_unit<false>(ap, (LAS char*)lds, bh >> 3, bh & 7, (pi & 1) ? s : 63 - s, lam); ++pi; } } }
    }
    SYNC(2);
    if (IN(3)) {
        LAS char* scr = (LAS char*)lds + wave * 17408;
        for (int it = gw; it < 544 * 16; it += NGW) lru_item<false>(lp, scr, it >> 4, it & 15, lane);
    }
    SYNC(3);
    if (IN(4)) {
        if (vcu >= 4 && vcu < 12) {
            const int gt = (vcu - 4) * 512 + tid; const int b = gt >> 10, ch = gt & 1023; const float* ag = AGG + (size_t)(b * 128) * 2048 + ch; float* cr = CARRY + (size_t)(b * 128) * 1024 + ch; float h = 0.f;
#pragma unroll 16
            for (int j = 0; j < 128; ++j) { cr[(size_t)j * 1024] = h; h = ag[(size_t)j * 2048] * h + ag[(size_t)j * 2048 + 1024]; }
            asm volatile("s_waitcnt vmcnt(0)" ::: "memory"); __syncthreads();
            if (tid == 0) { __builtin_amdgcn_fence(__ATOMIC_RELEASE, "agent"); asm volatile("s_waitcnt vmcnt(0)" ::: "memory"); __hip_atomic_fetch_add(barcnt + 32, 1u, __ATOMIC_RELAXED, __HIP_MEMORY_SCOPE_AGENT); }
        }
        { pg8::Gemm g{AO, WbaT, T, 1024, 1024, 1024}; pg8::StaticOrder S; S.init(T, 1024, G, bx); EpiM1 E{GA, TMP};
          pg8::gemm_phase<EpiM1, pg8::StaticOrder, true, true>(lds, g, S, E); }
        while (__builtin_amdgcn_readfirstlane((int)__hip_atomic_load(barcnt + 32, __ATOMIC_RELAXED, __HIP_MEMORY_SCOPE_AGENT)) < (G < 8 ? G : 8)) __builtin_amdgcn_s_sleep(2);
        __builtin_amdgcn_fence(__ATOMIC_ACQUIRE, "agent"); asm volatile("s_waitcnt vmcnt(0)" ::: "memory");
        for (int it = gw; it < 544 * 16; it += NGW) lru_final_light(lp, it >> 4, it & 15, lane);
    }
    SYNC(4);
    if (IN(5)) for (int rep = 0; rep < REPN(5); ++rep) {
        { pg8::Gemm g{BO, WblT, T, 1024, 1024, 1024}; pg8::StaticOrder S; S.init(T, 1024, G, bx); EpiM2 E{GB, TMP, MG};
          pg8::gemm_phase<EpiM2, pg8::StaticOrder, true, true>(lds, g, S, E); }
        { const int nheavy = (544 - 2 * G > 0 && 544 - 2 * G < G) ? 544 - 2 * G : 0, nlw = (G - nheavy) * 8;
          if (bx >= nheavy) { __syncthreads(); LAS float* scr = (LAS float*)(lds + wave * 16384);
              for (int r = (bx - nheavy) * 8 + wave; r < 16 * 128 + 64 * 32; r += nlw) {
                  if (r < 16 * 128) transpose_item(a.w_up, 1024, FF, a.norm_mlp, WupT, scr, r, lane); else transpose_item(a.w_down, FF, 1024, nullptr, WdnT, scr, r - 16 * 128, lane); } } }
    }
    SYNC(5);
    if (IN(6)) for (int rep = 0; rep < REPN(6); ++rep) {
        pg8::Gemm g{MG, WoT, T, 1024, 1024, 1024}; pg8::StaticOrder S; S.init(T, 1024, G, bx); EpiO E{a.x_prompt, a.x_sample, H, HB, RSS};
        pg8::gemm_phase<EpiO, pg8::StaticOrder, true, true>(lds, g, S, E);
    }
    SYNC(6);
    if (IN(7)) for (int rep = 0; rep < REPN(7); ++rep) {
        pg8::Gemm g{HB, WupT, T, FF, 1024, 1024}; pg8::StaticOrder S; S.init(T, FF, G, bx); EpiUp E{RSS, UP};
        pg8::gemm_phase<EpiUp, pg8::StaticOrder, true, true>(lds, g, S, E);
    }
    SYNC(7);
    if (IN(8)) {
        { pg8::Gemm g{UP, WdnT, TP, 1024, FF, FF}; pg8::StaticOrder S; S.init(TP, 1024, G, bx); EpiDown E{H};
          pg8::gemm_phase<EpiDown, pg8::StaticOrder, true, true>(lds, g, S, E); }
        { pg8::Gemm g{UP, WdnT, T, 1024, 512, FF}; SplitOrder S{G, bx}; EpiPart E{(float*)S4};
          pg8::gemm_phase<EpiPart, SplitOrder, true, true>(lds, g, S, E); }
    }
    SYNC(8);
    if (IN(9)) {
        f32x4 g[4];
#pragma unroll
        for (int j = 0; j < 4; ++j) g[j] = ((const f32x4*)a.norm_final)[lane + 64 * j];
        for (int m = gw; m < T; m += NGW) {
            f32x4* xr = (f32x4*)(H + (size_t)m * 1024);
            f32x4 v[4]; float s = 0.f;
#pragma unroll
            for (int j = 0; j < 4; ++j) v[j] = xr[lane + 64 * j];
            if (m >= TP) {
                const f32x4* pp = (const f32x4*)((const float*)S4 + (size_t)(m - TP) * 1024) + lane;
#pragma unroll
                for (int kc = 0; kc < 8; ++kc)
#pragma unroll
                    for (int j = 0; j < 4; ++j) v[j] += pp[(size_t)kc * 2048 * 256 + 64 * j];
            }
#pragma unroll
            for (int j = 0; j < 4; ++j) s += (v[j][0] * v[j][0] + v[j][1] * v[j][1]) + (v[j][2] * v[j][2] + v[j][3] * v[j][3]);
            const float rstd = 1.0f / sqrtf(wave_sum(s) * (1.0f / 1024.0f) + EPS);
#pragma unroll
            for (int j = 0; j < 4; ++j) xr[lane + 64 * j] = v[j] * rstd * g[j];
        }
    }
#undef IN
#undef SYNC
}

constexpr int NPH = 10;
#ifndef MK_LAUNCHES
#define MK_LAUNCHES 1
#endif
extern "C" void kernel_launch(void* const* d_in, const int* in_sizes, int n_in, void* d_out, int out_size, void* d_ws, size_t ws_size, hipStream_t stream) {
    static int grid = 0;
    if (grid == 0) {
        if (n_in != 25 || ws_size < WS_END) { fprintf(stderr, "kernel_launch: unexpected n_in %d / ws %zu (need %zu)\n", n_in, ws_size, (size_t)WS_END); grid = -1; return; }
        int dev = 0, cus = 0, per_cu = 0;
        hipGetDevice(&dev); hipDeviceGetAttribute(&cus, hipDeviceAttributeMultiprocessorCount, dev);
        if (hipFuncSetAttribute((const void*)mega, hipFuncAttributeMaxDynamicSharedMemorySize, LDS_BYTES) != hipSuccess) { fprintf(stderr, "hipFuncSetAttribute failed\n"); grid = -1; return; }
        hipOccupancyMaxActiveBlocksPerMultiprocessor(&per_cu, (const void*)mega, 512, LDS_BYTES);
        if (per_cu < 1) { fprintf(stderr, "occupancy query says %d\n", per_cu); per_cu = 1; }
        (void)hipGetLastError();
        grid = cus * 1;
    }
    if (grid < 0) return;
    if (hipMemsetAsync((char*)d_ws + WS_CTL, 0, 256, stream) != hipSuccess) { fprintf(stderr, "memset failed\n"); return; }
    if (hipMemsetAsync((char*)d_ws + WS_XB, 0, 16384, stream) != hipSuccess) { fprintf(stderr, "memset failed\n"); return; }
    Args a{};
    const float** pf = (const float**)&a;
    for (int i = 0; i < 25; ++i) pf[i] = (const float*)d_in[i];
    a.out = (float*)d_out; a.ws = (unsigned char*)d_ws;
#if MK_LAUNCHES == 1
#ifdef PROBE_PREFIX
    { a.ph_lo = 0; a.ph_hi = PROBE_PREFIX; a.flags = PROBE_FLAGS; void* args0[] = {&a};
      if (hipLaunchCooperativeKernel((const void*)mega, dim3(grid), dim3(512), args0, LDS_BYTES, stream) != hipSuccess) fprintf(stderr, "probe launch failed\n");
      if (hipMemsetAsync((char*)d_ws + WS_CTL, 0, 256, stream) != hipSuccess) fprintf(stderr, "memset failed\n"); }
#endif
    a.ph_lo = 0; a.ph_hi = NPH; a.flags = 0;
    void* args[] = {&a};
    hipError_t e = hipLaunchCooperativeKernel((const void*)mega, dim3(grid), dim3(512), args, LDS_BYTES, stream);
    if (e != hipSuccess) fprintf(stderr, "cooperative launch failed: %s (grid %d)\n", hipGetErrorString(e), grid);
#else
    for (int k = 0; k < NPH; ++k) { a.ph_lo = k; a.ph_hi = k + 1; hipLaunchKernelGGL(mega, dim3(grid), dim3(512), LDS_BYTES, stream, a); }
#endif
}
```
